# Optimizing an MI355X kernel written in HIP

```python
import jax, jax.numpy as jnp
from jax import lax
import numpy as np

D_MODEL = 1024
BATCH = 2
SEQ = 8192
DEPTH = 4

GRID_W = 64
CTX_LEN = 256
HEAD_DIM = 64
ATTN_WIDTH = D_MODEL // 2
N_Q_HEADS = ATTN_WIDTH // HEAD_DIM
N_KV_HEADS = 2
Q_GROUP = N_Q_HEADS // N_KV_HEADS
KV_WIDTH = N_KV_HEADS * HEAD_DIM
ATTN_SCALE = HEAD_DIM ** -0.5
Q_BLOCK = 128
ROPE_THETA = 10000.0
POOL_WINDOWS = (2, 4, 8, 16)
POOL_WIDTH = D_MODEL - ATTN_WIDTH
POOL_GROUP_DIM = POOL_WIDTH // len(POOL_WINDOWS)
IN_A_WIDTH = ATTN_WIDTH + 2 * KV_WIDTH + POOL_WIDTH
OUT_A_WIDTH = ATTN_WIDTH + POOL_WIDTH
CHUNK = 128
GMLP_WIDTH = D_MODEL
GMLP_GROUPS = 8
GMLP_GROUP_DIM = GMLP_WIDTH // GMLP_GROUPS
D_FF = 2816
N_MOD = 9
EPS = 1e-6
N_EVEN = (DEPTH + 1) // 2
N_ODD = DEPTH // 2

kernel_name = "hybrid_attn_pool_gmlp_dit_trunk"


def rms_norm(x, g):
    xf = x.astype(jnp.float32)
    y = xf * lax.rsqrt(jnp.mean(xf * xf, axis=-1, keepdims=True) + EPS)
    return (y * g.astype(jnp.float32)).astype(x.dtype)


def modulate(x, g, shift, scale):
    return rms_norm(x, g) * (1 + scale) + shift


def swiglu(h, w13, w2):
    a, b = jnp.split(h @ w13, 2, axis=-1)
    return (jax.nn.silu(a) * b) @ w2


def half_ffn(x, g, shift, scale, gate, w13, w2):
    return x + 0.5 * gate * swiglu(modulate(x, g, shift, scale), w13, w2)


def axial_rope_tables(n_tokens, dtype):
    n_rows = n_tokens // GRID_W
    rows = jnp.repeat(jnp.arange(n_rows), GRID_W).astype(jnp.float32)
    cols = jnp.tile(jnp.arange(GRID_W), n_rows).astype(jnp.float32)
    half = HEAD_DIM // 2
    inv_freq = ROPE_THETA ** (-jnp.arange(0, half, 2, dtype=jnp.float32) / half)
    ang_r = rows[:, None] * inv_freq[None, :]
    ang_c = cols[:, None] * inv_freq[None, :]
    return (jnp.cos(ang_r).astype(dtype), jnp.sin(ang_r).astype(dtype),
            jnp.cos(ang_c).astype(dtype), jnp.sin(ang_c).astype(dtype))


def rope_half(x, cos, sin):
    x1, x2 = jnp.split(x, 2, axis=-1)
    cos = cos[None, :, None, :]
    sin = sin[None, :, None, :]
    return jnp.concatenate([x1 * cos - x2 * sin, x1 * sin + x2 * cos], axis=-1)


def apply_axial_rope(x, tabs):
    cr, sr, cc, sc = tabs
    xr, xc = jnp.split(x, 2, axis=-1)
    return jnp.concatenate([rope_half(xr, cr, sr), rope_half(xc, cc, sc)], axis=-1)


def gqa_attend(q, k, v):
    b, nq = q.shape[:2]
    qg = q.reshape(b, nq, N_KV_HEADS, Q_GROUP, HEAD_DIM)
    sc = jnp.einsum('bqhgd,bkhd->bhgqk', qg, k, preferred_element_type=jnp.float32) * ATTN_SCALE
    pr = jax.nn.softmax(sc, axis=-1).astype(v.dtype)
    return jnp.einsum('bhgqk,bkhd->bqhgd', pr, v).reshape(b, nq, ATTN_WIDTH)


def latent_attention(q, k_lat, v_lat, k_ctx, v_ctx):
    b, s = q.shape[:2]
    k_all = jnp.concatenate([k_ctx, k_lat], axis=1)
    v_all = jnp.concatenate([v_ctx, v_lat], axis=1)
    nb = s // Q_BLOCK
    qb = jnp.moveaxis(q.reshape(b, nb, Q_BLOCK, N_Q_HEADS, HEAD_DIM), 1, 0)
    ob = lax.map(lambda qblk: gqa_attend(qblk, k_all, v_all), qb)
    return jnp.moveaxis(ob, 0, 1).reshape(b, s, ATTN_WIDTH)


def project_a(h, w_in, qk_g):
    b, n = h.shape[:2]
    z = h @ w_in
    q = rms_norm(z[..., :ATTN_WIDTH].reshape(b, n, N_Q_HEADS, HEAD_DIM), qk_g[0])
    k = rms_norm(z[..., ATTN_WIDTH:ATTN_WIDTH + KV_WIDTH].reshape(b, n, N_KV_HEADS, HEAD_DIM), qk_g[1])
    v = z[..., ATTN_WIDTH + KV_WIDTH:ATTN_WIDTH + 2 * KV_WIDTH].reshape(b, n, N_KV_HEADS, HEAD_DIM)
    p = z[..., ATTN_WIDTH + 2 * KV_WIDTH:]
    return q, k, v, p


def project_ctx_kv(h, w_in, qk_g):
    b, n = h.shape[:2]
    z = h @ w_in[:, ATTN_WIDTH:ATTN_WIDTH + 2 * KV_WIDTH]
    k = rms_norm(z[..., :KV_WIDTH].reshape(b, n, N_KV_HEADS, HEAD_DIM), qk_g[1])
    v = z[..., KV_WIDTH:].reshape(b, n, N_KV_HEADS, HEAD_DIM)
    return k, v


def multiscale_pool(p, pool_w, pool_scale):
    n = p.shape[1]
    pf = p.astype(jnp.float32)
    cs = jnp.concatenate([jnp.zeros_like(pf[:, :1]), jnp.cumsum(pf, axis=1)], axis=1)
    t = jnp.arange(n)
    outs = []
    for gi, w in enumerate(POOL_WINDOWS):
        sl = slice(gi * POOL_GROUP_DIM, (gi + 1) * POOL_GROUP_DIM)
        lo = jnp.clip(t - w // 2, 0, n)
        hi = jnp.clip(t + w // 2, 0, n)
        csg = cs[..., sl]
        mean = (csg[:, hi] - csg[:, lo]) / (hi - lo).astype(jnp.float32)[None, :, None]
        outs.append((mean - pf[..., sl]).astype(p.dtype) @ pool_w[gi])
    return jnp.concatenate(outs, axis=-1) * pool_scale


def combine_a(attn, p, pool_w, pool_scale, w_out):
    return jnp.concatenate([attn, multiscale_pool(p, pool_w, pool_scale)], axis=-1) @ w_out


def mixer_c(h, w_in, v_g, w_sp, b_sp, w_out):
    b, n = h.shape[:2]
    z = jax.nn.gelu(h @ w_in)
    u, v = jnp.split(z, 2, axis=-1)
    v = rms_norm(v, v_g)
    vc = v.reshape(b, n // CHUNK, CHUNK, GMLP_GROUPS, GMLP_GROUP_DIM)
    sv = jnp.einsum('gpq,bnqgc->bnpgc', w_sp, vc) + b_sp.T[None, None, :, :, None]
    return (u * sv.reshape(b, n, GMLP_WIDTH)) @ w_out


def setup_inputs(seed: int = 0) -> dict:
    key = jax.random.key(seed)
    ks = jax.random.split(key, 20)
    f32 = jnp.float32

    def nrm(k, shape, fan_in):
        return jax.random.normal(k, shape, f32) * (fan_in ** -0.5)

    def gain(k, shape):
        return 1.0 + 0.05 * jax.random.normal(k, shape, f32)

    return {
        "x": jax.random.normal(ks[0], (BATCH, SEQ, D_MODEL), f32),
        "c": jax.random.normal(ks[1], (BATCH, D_MODEL), f32),
        "ctx": jax.random.normal(ks[2], (BATCH, CTX_LEN, D_MODEL), f32),
        "c_ctx": jax.random.normal(ks[3], (D_MODEL,), f32),
        "w_mod": 0.5 * nrm(ks[4], (DEPTH, D_MODEL, N_MOD * D_MODEL), D_MODEL),
        "b_mod": 0.01 * jax.random.normal(ks[5], (DEPTH, N_MOD * D_MODEL), f32),
        "norm_g": gain(ks[6], (DEPTH, 3, D_MODEL)),
        "ffn_w13": nrm(ks[7], (DEPTH, 2, D_MODEL, 2 * D_FF), D_MODEL),
        "ffn_w2": nrm(ks[8], (DEPTH, 2, D_FF, D_MODEL), D_FF),
        "w_in_a": nrm(ks[9], (N_EVEN, D_MODEL, IN_A_WIDTH), D_MODEL),
        "qk_norm_g": gain(ks[10], (N_EVEN, 2, HEAD_DIM)),
        "pool_w": nrm(ks[11], (N_EVEN, len(POOL_WINDOWS), POOL_GROUP_DIM, POOL_GROUP_DIM), POOL_GROUP_DIM),
        "pool_scale": gain(ks[12], (N_EVEN, POOL_WIDTH)),
        "w_out_a": nrm(ks[13], (N_EVEN, OUT_A_WIDTH, D_MODEL), OUT_A_WIDTH),
        "w_in_c": nrm(ks[14], (N_ODD, D_MODEL, 2 * GMLP_WIDTH), D_MODEL),
        "v_norm_g": gain(ks[15], (N_ODD, GMLP_WIDTH)),
        "w_sp": nrm(ks[16], (N_ODD, GMLP_GROUPS, CHUNK, CHUNK), CHUNK),
        "b_sp": gain(ks[17], (N_ODD, GMLP_GROUPS, CHUNK)),
        "w_out_c": nrm(ks[18], (N_ODD, GMLP_WIDTH, D_MODEL), GMLP_WIDTH),
    }


def reference(x, c, ctx, c_ctx, w_mod, b_mod, norm_g, ffn_w13, ffn_w2,
              w_in_a, qk_norm_g, pool_w, pool_scale, w_out_a,
              w_in_c, v_norm_g, w_sp, b_sp, w_out_c):
    b, s, d = x.shape
    rope_tabs = axial_rope_tables(s, x.dtype)
    silu_c = jax.nn.silu(c)
    silu_cc = jax.nn.silu(c_ctx)
    cs = ctx
    for i in range(DEPTH):
        m = (silu_c @ w_mod[i] + b_mod[i]).reshape(b, 1, N_MOD, d)
        reads_ctx = (i % 2 == 0)
        later_reads_ctx = any(j % 2 == 0 for j in range(i + 1, DEPTH))
        ctx_needed = reads_ctx or later_reads_ctx
        if ctx_needed:
            mc = (silu_cc @ w_mod[i] + b_mod[i]).reshape(1, 1, N_MOD, d)
            cs = half_ffn(cs, norm_g[i, 0], mc[:, :, 0], mc[:, :, 1], mc[:, :, 2],
                          ffn_w13[i, 0], ffn_w2[i, 0])
        x = half_ffn(x, norm_g[i, 0], m[:, :, 0], m[:, :, 1], m[:, :, 2], ffn_w13[i, 0], ffn_w2[i, 0])

        h = modulate(x, norm_g[i, 1], m[:, :, 3], m[:, :, 4])
        if i % 2 == 0:
            e = i // 2
            hc = modulate(cs, norm_g[i, 1], mc[:, :, 3], mc[:, :, 4])
            if later_reads_ctx:
                qc, kc, vc, pc = project_a(hc, w_in_a[e], qk_norm_g[e])
            else:
                kc, vc = project_ctx_kv(hc, w_in_a[e], qk_norm_g[e])
            q, k, v, p = project_a(h, w_in_a[e], qk_norm_g[e])
            q = apply_axial_rope(q, rope_tabs)
            k = apply_axial_rope(k, rope_tabs)
            attn = latent_attention(q, k, v, kc, vc)
            x = x + m[:, :, 5] * combine_a(attn, p, pool_w[e], pool_scale[e], w_out_a[e])
            if later_reads_ctx:
                attn_c = gqa_attend(qc, kc, vc)
                cs = cs + mc[:, :, 5] * combine_a(attn_c, pc, pool_w[e], pool_scale[e], w_out_a[e])
        else:
            o = i // 2
            x = x + m[:, :, 5] * mixer_c(h, w_in_c[o], v_norm_g[o], w_sp[o], b_sp[o], w_out_c[o])
            if later_reads_ctx:
                hc = modulate(cs, norm_g[i, 1], mc[:, :, 3], mc[:, :, 4])
                cs = cs + mc[:, :, 5] * mixer_c(hc, w_in_c[o], v_norm_g[o], w_sp[o], b_sp[o], w_out_c[o])

        if later_reads_ctx:
            cs = half_ffn(cs, norm_g[i, 2], mc[:, :, 6], mc[:, :, 7], mc[:, :, 8],
                          ffn_w13[i, 1], ffn_w2[i, 1])
        x = half_ffn(x, norm_g[i, 2], m[:, :, 6], m[:, :, 7], m[:, :, 8], ffn_w13[i, 1], ffn_w2[i, 1])
    return x
```

```cpp
#include <hip/hip_runtime.h>
#include <hip/hip_cooperative_groups.h>
#include <hip/hip_bf16.h>
#include <cstdio>
#include <cstdint>
namespace cg = cooperative_groups;

#ifndef RESID_NBUF
#define RESID_NBUF 3
#endif
#ifndef MK_PER_PHASE
#define MK_PER_PHASE 0
#endif

#define LAS __attribute__((address_space(3)))
typedef unsigned short bf16_t;
typedef short bf16x8 __attribute__((ext_vector_type(8)));
typedef float f32x4 __attribute__((ext_vector_type(4)));
typedef float f32x2 __attribute__((ext_vector_type(2)));
typedef unsigned u32x4 __attribute__((ext_vector_type(4)));
typedef unsigned u32x2 __attribute__((ext_vector_type(2)));

constexpr int DM = 1024, SEQ = 8192, CTXL = 256, ML = 16384, MC = 512, MT = ML + MC, DFF = 2816, NFF = 5632;
constexpr int KVROWS = CTXL + SEQ;
constexpr int NMOD = 9 * DM;
constexpr float EPS = 1e-6f;
constexpr float QSCALE = 0.125f * 1.4426950408889634f;

constexpr size_t SZ_W13 = (size_t)NFF * DM * 2, SZ_W2 = (size_t)DM * DFF * 2, SZ_WINA = (size_t)1280 * DM * 2, SZ_WSQ = (size_t)DM * DM * 2, SZ_WINC = (size_t)2048 * DM * 2, SZ_WSP = (size_t)8 * 128 * 128 * 2;
constexpr size_t WS_W13 = 0;
constexpr size_t WS_W2 = WS_W13 + 8 * SZ_W13;
constexpr size_t WS_WINA = WS_W2 + 8 * SZ_W2;
constexpr size_t WS_WOUTA = WS_WINA + 2 * SZ_WINA;
constexpr size_t WS_WINC = WS_WOUTA + 2 * SZ_WSQ;
constexpr size_t WS_WOUTC = WS_WINC + 2 * SZ_WINC;
constexpr size_t WS_WSP = WS_WOUTC + 2 * SZ_WSQ;
constexpr size_t WS_MOD = WS_WSP + 2 * SZ_WSP;
constexpr size_t WS_BIAS = WS_MOD + (size_t)4 * 3 * NMOD * 4;
constexpr size_t WS_GS = WS_BIAS + (size_t)12 * 3 * NFF * 4;
constexpr size_t WS_ROPE = WS_GS + (size_t)12 * 3 * DM * 4;
constexpr size_t WS_SS = WS_ROPE + (size_t)128 * 16 * 2 * 4;
constexpr size_t WS_VSS = WS_SS + (size_t)MT * 16 * 4;
constexpr size_t WS_X = WS_VSS + (size_t)MT * 16 * 4;
constexpr size_t WS_AH = WS_X + (size_t)MT * DM * 4;
constexpr size_t WS_H = WS_AH + (size_t)MT * DM * 2;
constexpr size_t WS_Q = WS_H + (size_t)MT * DFF * 2;
constexpr size_t WS_KB = WS_Q + (size_t)MT * 512 * 2;
constexpr size_t WS_VB = WS_KB + (size_t)2 * KVROWS * 128 * 2;
constexpr size_t WS_P = WS_VB + (size_t)2 * KVROWS * 128 * 2;
constexpr size_t WS_AO = WS_P + (size_t)MT * 512 * 2;
constexpr size_t WS_CTL = WS_AO + (size_t)MT * DM * 2;
constexpr size_t CTL_BYTES = 16384;
constexpr size_t WS_END = WS_CTL + CTL_BYTES;
static_assert(WS_W2 % 256 == 0 && WS_MOD % 256 == 0 && WS_BIAS % 256 == 0 && WS_SS % 256 == 0 && WS_X % 256 == 0 && WS_H % 256 == 0 && WS_KB % 256 == 0 && WS_AO % 256 == 0, "ws alignment");

constexpr int LDS_BYTES = 147456;
constexpr int LDS_SILU = 131072;
constexpr int LDS_MISC = LDS_BYTES - 256;

__device__ __forceinline__ unsigned cvt_pk_bf16(float lo, float hi) { unsigned r; asm volatile("v_cvt_pk_bf16_f32 %0, %1, %2" : "=v"(r) : "v"(lo), "v"(hi)); return r; }
__device__ __forceinline__ float bf2f(unsigned short h) { return __uint_as_float((unsigned)h << 16); }
__device__ __forceinline__ float bflo(unsigned w) { return __uint_as_float(w << 16); }
__device__ __forceinline__ float bfhi(unsigned w) { return __uint_as_float(w & 0xffff0000u); }
typedef _Float16 h16x2 __attribute__((ext_vector_type(2)));
__device__ __forceinline__ unsigned pk_h2(float lo, float hi) { f32x2 v; v.x = __builtin_fminf(__builtin_fmaxf(lo, -65000.f), 65000.f); v.y = __builtin_fminf(__builtin_fmaxf(hi, -65000.f), 65000.f);
    const h16x2 h = __builtin_convertvector(v, h16x2); return __builtin_bit_cast(unsigned, h); }
__device__ __forceinline__ f32x2 unpk_h2(unsigned w) { const h16x2 h = __builtin_bit_cast(h16x2, w); return __builtin_convertvector(h, f32x2); }
__device__ __forceinline__ float fast_rcp(float x) { return __builtin_amdgcn_rcpf(x); }
__device__ __forceinline__ float silu_f(float a) { return a * fast_rcp(1.0f + __builtin_amdgcn_exp2f(-1.4426950408889634f * a)); }
__device__ __forceinline__ float gelu_tanh_f(float x) { const float t = x * (-2.3022081986f + -0.1029432396f * x * x); return x * fast_rcp(1.0f + __builtin_amdgcn_exp2f(t)); }
__device__ __forceinline__ float wave_sum(float v) {
#pragma unroll
    for (int o = 1; o < 64; o <<= 1) v += __shfl_xor(v, o);
    return v;
}
__device__ __forceinline__ int mod_index_of_tile(int pm) { return pm < 32 ? 0 : (pm < 64 ? 1 : 2); }
__device__ __forceinline__ float row_rstd16(const float* SS, int row, int fq) {
    const f32x4 v = *(const f32x4*)(SS + (size_t)row * 16 + 4 * fq);
    float s = (v.x + v.y) + (v.z + v.w);
    s += __shfl_xor(s, 16); s += __shfl_xor(s, 32);
    return 1.0f / sqrtf(s * (1.0f / 1024.0f) + EPS);
}

__device__ __forceinline__ void row_rstd16x8(const float* SS, int row0, int fq, float (&rs)[2][4]) {
    f32x4 v[2][4];
#pragma unroll
    for (int ai = 0; ai < 2; ++ai)
#pragma unroll
        for (int m = 0; m < 4; ++m) v[ai][m] = *(const f32x4*)(SS + (size_t)(row0 + ai * 128 + m * 16) * 16 + 4 * fq);
#pragma unroll
    for (int ai = 0; ai < 2; ++ai)
#pragma unroll
        for (int m = 0; m < 4; ++m) { float t = (v[ai][m].x + v[ai][m].y) + (v[ai][m].z + v[ai][m].w); t += __shfl_xor(t, 16); t += __shfl_xor(t, 32); rs[ai][m] = 1.0f / sqrtf(t * (1.0f / 1024.0f) + EPS); }
}

namespace pg8 {
constexpr int BM = 256, BK = 64, HALF = 128, HTB = HALF * BK * 2, STAGE_BYTES = 8 * HTB, NXCD = 8, WGM = 8;
__host__ __device__ __forceinline__ int lds_byte(int r, int c) { const int st = (r >> 4) * 2 + (c >> 5), rr = r & 15, cc = c & 31, ob = rr * 64 + cc * 2; return st * 1024 + (ob ^ (((ob >> 9) & 1) << 5)); }
__host__ __device__ __forceinline__ void stage_rc(int b, int& R, int& C) { const int st = b / 1024, sb = b % 1024, swz = sb ^ (((sb >> 9) & 1) << 5); R = (st >> 1) * 16 + swz / 64; C = (st & 1) * 32 + (swz % 64) / 2; }
__host__ __device__ __forceinline__ int perm32(int rho) { const int n = rho >> 4, i = rho & 15; return 8 * (i >> 2) + 4 * n + (i & 3); }
struct Unit { int pm, pn; };
struct Gemm { const bf16_t* A; const bf16_t* Bt; int M, N, K; };
struct StaticOrder {
    int nM, nN, nwg, G, c;
    __host__ __device__ void init(int M, int N, int G_, int c_) { nM = M / BM; nN = N / BM; nwg = nM * nN; G = G_; c = c_; }
    __host__ __device__ bool next(int i, Unit& u) const {
        const long L = (long)i * G + c; if (L >= nwg) return false;
        int wgid = (int)L; { const int q = nwg / NXCD, r = nwg % NXCD, xcd = wgid % NXCD, off = wgid / NXCD; wgid = (xcd < r ? xcd * (q + 1) : r * (q + 1) + (xcd - r) * q) + off; }
        const int nig = WGM * nN, gid = wgid / nig, fm = gid * WGM, gsz = (nM - fm) < WGM ? (nM - fm) : WGM;
        u.pm = fm + ((wgid % nig) % gsz); u.pn = (wgid % nig) / gsz; return true;
    }
    __device__ __forceinline__ void a_ready(const Unit&) const {}
    __device__ __forceinline__ void done(const Unit&) const {}
};

template <class Epi, class Sched, bool ALIGN_EPI = false, bool SP2 = false>
__device__ __forceinline__ void gemm_phase(LAS unsigned char* lds, const Gemm g, const Sched& S, const Epi& E) {
    int tid_ = threadIdx.x; asm volatile("" : "+v"(tid_));
    const int tid = tid_, wid = __builtin_amdgcn_readfirstlane(tid >> 6), lane = tid & 63, wr = wid >> 2, wc = wid & 3, fr = lane & 15, fq = lane >> 4;
    const int K = g.K, nt = K / BK;
    unsigned voffA[2], voffB[2];
#pragma unroll
    for (int i = 0; i < 2; ++i) { int R, C; stage_rc(tid * 16 + i * 8192, R, C); const int Rb = Epi::PERM ? ((R & ~31) + perm32(R & 31)) : R;
        voffA[i] = (unsigned)(R * K + C) * 2u; voffB[i] = (unsigned)(Rb * K + C) * 2u; }
    const size_t kstep = (size_t)(BK * 2);
    const size_t hstep = (size_t)HALF * K * 2;
    const size_t tstep = 2 * hstep;
    const unsigned ldsw = (unsigned)wid * 1024u;
    const int aoff = lds_byte(wr * 64 + fr, fq * 8), boff = lds_byte(wc * 32 + fr, fq * 8);
#define PG8_SA(b, h) (((b) * 2 + (h)) * HTB)
#define PG8_SB(b, h) ((4 + (b) * 2 + (h)) * HTB)
#define PG8_STAGE(bufoff, gbase, voff) do { _Pragma("unroll") for (int _i = 0; _i < 2; ++_i) \
        __builtin_amdgcn_global_load_lds((const unsigned*)((const char*)(gbase) + (voff)[_i]), (LAS unsigned*)(lds + (bufoff) + ldsw + _i * 8192), 16, 0, 0); } while (0)
#define PG8_LDA(dst, b, h) do { _Pragma("unroll") for (int m = 0; m < 4; ++m) _Pragma("unroll") for (int k = 0; k < 2; ++k) dst[m][k] = *(const LAS bf16x8*)(lds + PG8_SA(b, h) + aoff + m * 2048 + k * 1024); } while (0)
#define PG8_LDB(dst, b, h) do { _Pragma("unroll") for (int n = 0; n < 2; ++n) _Pragma("unroll") for (int k = 0; k < 2; ++k) dst[n][k] = *(const LAS bf16x8*)(lds + PG8_SB(b, h) + boff + n * 2048 + k * 1024); } while (0)
#define PG8_MMA(ai, bj, At, Bt) do { __builtin_amdgcn_s_setprio(1); _Pragma("unroll") for (int m = 0; m < 4; ++m) _Pragma("unroll") for (int n = 0; n < 2; ++n) _Pragma("unroll") for (int k = 0; k < 2; ++k) \
        acc[ai][bj][m][n] = __builtin_amdgcn_mfma_f32_16x16x32_bf16(Bt[n][k], At[m][k], acc[ai][bj][m][n], 0, 0, 0); __builtin_amdgcn_s_setprio(0); } while (0)
#define PG8_WAIT_V(n) asm volatile("s_waitcnt vmcnt(" #n ")" ::: "memory")
#define PG8_WAIT_L(n) asm volatile("s_waitcnt lgkmcnt(" #n ")" ::: "memory")
#define PG8_BAR __builtin_amdgcn_s_barrier()
#define PG8_SCHED __builtin_amdgcn_sched_barrier(0)
    Unit cur, nxt; int ui = 0;
    if (!S.next(0, cur)) return;
    f32x4 acc[2][2][4][2];
#pragma unroll
    for (int a = 0; a < 2; ++a)
#pragma unroll
        for (int b = 0; b < 2; ++b)
#pragma unroll
            for (int m = 0; m < 4; ++m)
#pragma unroll
                for (int n = 0; n < 2; ++n) acc[a][b][m][n] = (f32x4){0.f, 0.f, 0.f, 0.f};
    bf16x8 At[4][2], B0[2][2], B1[2][2];
    const char* cA = (const char*)g.A + (size_t)cur.pm * tstep; const char* cB = (const char*)g.Bt + (size_t)cur.pn * tstep;
    S.a_ready(cur);
    if constexpr (SP2) {
        PG8_STAGE(PG8_SB(0, 0), cB, voffB); PG8_STAGE(PG8_SB(0, 1), cB + hstep, voffB); PG8_STAGE(PG8_SA(0, 0), cA, voffA); PG8_STAGE(PG8_SA(0, 1), cA + hstep, voffA);
        if (wr == 1) PG8_BAR;
        PG8_WAIT_V(2); PG8_BAR;
        PG8_STAGE(PG8_SB(1, 0), cB + kstep, voffB); PG8_STAGE(PG8_SA(1, 0), cA + kstep, voffA); PG8_STAGE(PG8_SB(1, 1), cB + hstep + kstep, voffB);
        PG8_WAIT_V(6); PG8_BAR;
    } else {
        PG8_STAGE(PG8_SB(0, 0), cB, voffB); PG8_STAGE(PG8_SA(0, 0), cA, voffA); PG8_STAGE(PG8_SB(0, 1), cB + hstep, voffB); PG8_STAGE(PG8_SA(0, 1), cA + hstep, voffA);
        if (wr == 1) PG8_BAR;
        PG8_WAIT_V(4); PG8_BAR;
        PG8_STAGE(PG8_SB(1, 0), cB + kstep, voffB); PG8_STAGE(PG8_SA(1, 0), cA + kstep, voffA); PG8_STAGE(PG8_SB(1, 1), cB + hstep + kstep, voffB);
        PG8_WAIT_V(6); PG8_BAR;
    }
    for (;;) {
        const bool has_next = S.next(ui + 1, nxt);
        const char* nA = has_next ? (const char*)g.A + (size_t)nxt.pm * tstep : cA; const char* nB = has_next ? (const char*)g.Bt + (size_t)nxt.pn * tstep : cB;
        for (int t = 0; t < nt; t += 2) {
            const bool last = (t == nt - 2);
            const char* a1 = cA + (size_t)(t + 1) * kstep;
            const char* a2 = last ? nA : cA + (size_t)(t + 2) * kstep; const char* b2 = last ? nB : cB + (size_t)(t + 2) * kstep;
            const char* a3 = a2 + kstep; const char* b3 = b2 + kstep;
            if (last && has_next) S.a_ready(nxt);
            if constexpr (SP2) {
            PG8_LDB(B0, 0, 0); PG8_LDB(B1, 0, 1); PG8_SCHED; PG8_LDA(At, 0, 0); PG8_STAGE(PG8_SA(1, 1), a1 + hstep, voffA);
            PG8_WAIT_V(8); PG8_WAIT_L(0); PG8_BAR; PG8_MMA(0, 0, At, B0); PG8_MMA(0, 1, At, B1); PG8_BAR; PG8_SCHED;
            PG8_LDA(At, 0, 1); PG8_STAGE(PG8_SB(0, 0), b2, voffB); PG8_STAGE(PG8_SB(0, 1), b2 + hstep, voffB); PG8_STAGE(PG8_SA(0, 0), a2, voffA);
            PG8_WAIT_V(8); PG8_WAIT_L(0); PG8_BAR; PG8_MMA(1, 0, At, B0); PG8_MMA(1, 1, At, B1); PG8_BAR; PG8_SCHED;
            PG8_LDB(B0, 1, 0); PG8_LDB(B1, 1, 1); PG8_SCHED; PG8_LDA(At, 1, 0); PG8_STAGE(PG8_SA(0, 1), a2 + hstep, voffA);
            PG8_WAIT_V(8); PG8_WAIT_L(0); PG8_BAR; PG8_MMA(0, 0, At, B0); PG8_MMA(0, 1, At, B1); PG8_BAR; PG8_SCHED;
            PG8_LDA(At, 1, 1); PG8_STAGE(PG8_SB(1, 0), b3, voffB); PG8_STAGE(PG8_SB(1, 1), b3 + hstep, voffB); PG8_STAGE(PG8_SA(1, 0), a3, voffA);
            PG8_WAIT_V(8); PG8_WAIT_L(0); PG8_BAR; PG8_MMA(1, 0, At, B0); PG8_MMA(1, 1, At, B1); PG8_BAR; PG8_SCHED;
            } else {
            PG8_LDB(B0, 0, 0); PG8_SCHED; PG8_LDA(At, 0, 0); PG8_STAGE(PG8_SA(1, 1), a1 + hstep, voffA);
            PG8_WAIT_L(8); PG8_BAR; PG8_WAIT_L(0); PG8_MMA(0, 0, At, B0); PG8_BAR; PG8_SCHED;
            PG8_LDB(B1, 0, 1); PG8_STAGE(PG8_SB(0, 0), b2, voffB);
            PG8_BAR; PG8_WAIT_L(0); PG8_MMA(0, 1, At, B1); PG8_BAR;
            PG8_LDA(At, 0, 1); PG8_STAGE(PG8_SA(0, 0), a2, voffA);
            PG8_BAR; PG8_WAIT_L(0); PG8_MMA(1, 0, At, B0); PG8_BAR; PG8_SCHED;
            PG8_STAGE(PG8_SB(0, 1), b2 + hstep, voffB);
            PG8_WAIT_V(6); PG8_BAR; PG8_MMA(1, 1, At, B1); PG8_BAR;
            PG8_LDB(B0, 1, 0); PG8_SCHED; PG8_LDA(At, 1, 0); PG8_STAGE(PG8_SA(0, 1), a2 + hstep, voffA);
            PG8_WAIT_L(8); PG8_BAR; PG8_WAIT_L(0); PG8_MMA(0, 0, At, B0); PG8_BAR; PG8_SCHED;
            PG8_LDB(B1, 1, 1); PG8_STAGE(PG8_SB(1, 0), b3, voffB);
            PG8_BAR; PG8_WAIT_L(0); PG8_MMA(0, 1, At, B1); PG8_BAR;
            PG8_LDA(At, 1, 1); PG8_STAGE(PG8_SA(1, 0), a3, voffA);
            PG8_BAR; PG8_WAIT_L(0); PG8_MMA(1, 0, At, B0); PG8_BAR; PG8_SCHED;
            PG8_STAGE(PG8_SB(1, 1), b3 + hstep, voffB);
            PG8_WAIT_V(6); PG8_BAR; PG8_MMA(1, 1, At, B1); PG8_BAR;
            }
        }
        if constexpr (ALIGN_EPI) { if (wr == 0) PG8_BAR; }
        { int fr_e = fr, fq_e = fq; asm volatile("" : "+v"(fr_e), "+v"(fq_e)); E(acc, cur, wr, wc, fr_e, fq_e); }
        S.done(cur);
        if (!has_next) break;
#pragma unroll
        for (int a = 0; a < 2; ++a)
#pragma unroll
            for (int b = 0; b < 2; ++b)
#pragma unroll
                for (int m = 0; m < 4; ++m)
#pragma unroll
                    for (int n = 0; n < 2; ++n) acc[a][b][m][n] = (f32x4){0.f, 0.f, 0.f, 0.f};
        cur = nxt; cA = nA; cB = nB; ++ui;
        if constexpr (ALIGN_EPI) { if (wr == 1) PG8_BAR; }
    }
    PG8_WAIT_V(0);
    if constexpr (!ALIGN_EPI) { if (wr == 0) PG8_BAR; }
    PG8_BAR;
#undef PG8_SA
#undef PG8_SB
#undef PG8_STAGE
#undef PG8_LDA
#undef PG8_LDB
#undef PG8_MMA
#undef PG8_WAIT_V
#undef PG8_WAIT_L
#undef PG8_BAR
#undef PG8_SCHED
}

struct EpiSwiGLU {
    static constexpr bool PERM = true;
    bf16_t* H; const float* SS; const float* bias;
    __device__ __forceinline__ void operator()(const f32x4 (&acc)[2][2][4][2], const Unit& u, int wr, int wc, int fr, int fq) const {
        const int mi = mod_index_of_tile(u.pm);
        const float* bp = bias + (size_t)mi * NFF + u.pn * 256 + wc * 32 + 8 * fq;
        f32x4 bv[2][2];
#pragma unroll
        for (int bj = 0; bj < 2; ++bj)
#pragma unroll
            for (int n = 0; n < 2; ++n) bv[bj][n] = *(const f32x4*)(bp + bj * 128 + 4 * n);
        const int row0 = u.pm * 256 + wr * 64 + fr;
        float rsv[2][4]; row_rstd16x8(SS, row0, fq, rsv);
#pragma unroll
        for (int ai = 0; ai < 2; ++ai)
#pragma unroll
            for (int m = 0; m < 4; ++m) {
                const int row = row0 + ai * 128 + m * 16;
                const float rs = rsv[ai][m];
                float h[8];
#pragma unroll
                for (int n = 0; n < 2; ++n) {
                    const f32x4 a = acc[ai][0][m][n] * rs + bv[0][n], b = acc[ai][1][m][n] * rs + bv[1][n];
                    const f32x4 t = a * -1.4426950408889634f;
                    f32x4 e; e.x = __builtin_amdgcn_exp2f(t.x); e.y = __builtin_amdgcn_exp2f(t.y); e.z = __builtin_amdgcn_exp2f(t.z); e.w = __builtin_amdgcn_exp2f(t.w);
                    const f32x4 d = e + 1.0f;
                    f32x4 r; r.x = fast_rcp(d.x); r.y = fast_rcp(d.y); r.z = fast_rcp(d.z); r.w = fast_rcp(d.w);
                    const f32x4 hv = (a * r) * b;
                    h[n * 4 + 0] = hv.x; h[n * 4 + 1] = hv.y; h[n * 4 + 2] = hv.z; h[n * 4 + 3] = hv.w;
                }
                u32x4 w; w.x = cvt_pk_bf16(h[0], h[1]); w.y = cvt_pk_bf16(h[2], h[3]); w.z = cvt_pk_bf16(h[4], h[5]); w.w = cvt_pk_bf16(h[6], h[7]);
                *(u32x4*)(H + (size_t)row * DFF + u.pn * 128 + wc * 32 + 8 * fq) = w;
            }
    }
};

struct EpiResid {
    static constexpr bool PERM = true;
    const float* xin_lat; const float* xin_ctx; const bf16_t* xin_bf; bf16_t* xout_bf; float* xout_f32; const float* gate; const float* gsn; bf16_t* AH; float* SS; float fac; int pad;
    template <bool IN_F32> __device__ __forceinline__ void body(const f32x4 (&acc)[2][2][4][2], const Unit& u, int wr, int wc, int fr, int fq) const {
        const int mi = mod_index_of_tile(u.pm);
        const int col0 = u.pn * 256 + wc * 32 + 8 * fq;
        f32x4 gv[2][2], sv[2][2];
#pragma unroll
        for (int bj = 0; bj < 2; ++bj)
#pragma unroll
            for (int n = 0; n < 2; ++n) {
                gv[bj][n] = *(const f32x4*)(gate + (size_t)mi * NMOD + col0 + bj * 128 + 4 * n) * fac;
                sv[bj][n] = gsn ? *(const f32x4*)(gsn + (size_t)mi * DM + col0 + bj * 128 + 4 * n) : (f32x4){0.f, 0.f, 0.f, 0.f};
            }
        const int row0 = u.pm * 256 + wr * 64 + fr;
        constexpr int NBUF = 3;
        f32x4 xf[IN_F32 ? NBUF : 1][2][2];
        u32x4 xb[IN_F32 ? 1 : NBUF][2];
#define RES_LOAD(g, buf) do { const int row_ = row0 + ((g) >> 2) * 128 + ((g) & 3) * 16; \
            if constexpr (IN_F32) { const float* xp_ = (row_ < ML) ? xin_lat + (size_t)row_ * DM : xin_ctx + (size_t)(row_ - ML) * DM; \
                _Pragma("unroll") for (int bj = 0; bj < 2; ++bj) { xf[buf][bj][0] = *(const f32x4*)(xp_ + col0 + bj * 128); xf[buf][bj][1] = *(const f32x4*)(xp_ + col0 + bj * 128 + 4); } } \
            else { _Pragma("unroll") for (int bj = 0; bj < 2; ++bj) xb[buf][bj] = *(const u32x4*)(xin_bf + (size_t)row_ * DM + col0 + bj * 128); } } while (0)
#pragma unroll
        for (int g = 0; g < NBUF - 1; ++g) RES_LOAD(g, g);
#pragma unroll
        for (int g = 0; g < 8; ++g) {
            const int ai = g >> 2, m = g & 3;
            if (g + NBUF - 1 < 8) RES_LOAD(g + NBUF - 1, (g + NBUF - 1) % NBUF);
            const int row = row0 + ai * 128 + m * 16;
            float ssq = 0.f;
#pragma unroll
            for (int bj = 0; bj < 2; ++bj) {
                f32x4 x0, x1;
                if constexpr (IN_F32) { x0 = xf[g % NBUF][bj][0]; x1 = xf[g % NBUF][bj][1]; }
                else { const u32x4 w = xb[g % NBUF][bj]; const f32x2 p0 = unpk_h2(w.x), p1 = unpk_h2(w.y), p2 = unpk_h2(w.z), p3 = unpk_h2(w.w); x0 = (f32x4){p0.x, p0.y, p1.x, p1.y}; x1 = (f32x4){p2.x, p2.y, p3.x, p3.y}; }
                const f32x4 y0 = x0 + gv[bj][0] * acc[ai][bj][m][0], y1 = x1 + gv[bj][1] * acc[ai][bj][m][1];
                if (xout_f32) { float* op = xout_f32 + (size_t)row * DM; *(f32x4*)(op + col0 + bj * 128) = y0; *(f32x4*)(op + col0 + bj * 128 + 4) = y1; }
                else { u32x4 w; w.x = pk_h2(y0.x, y0.y); w.y = pk_h2(y0.z, y0.w); w.z = pk_h2(y1.x, y1.y); w.w = pk_h2(y1.z, y1.w);
                    *(u32x4*)(xout_bf + (size_t)row * DM + col0 + bj * 128) = w; }
                ssq += (y0.x * y0.x + y0.y * y0.y) + (y0.z * y0.z + y0.w * y0.w) + (y1.x * y1.x + y1.y * y1.y) + (y1.z * y1.z + y1.w * y1.w);
                if (gsn) {
                    const f32x4 a0 = y0 * sv[bj][0], a1 = y1 * sv[bj][1];
                    u32x4 w; w.x = cvt_pk_bf16(a0.x, a0.y); w.y = cvt_pk_bf16(a0.z, a0.w); w.z = cvt_pk_bf16(a1.x, a1.y); w.w = cvt_pk_bf16(a1.z, a1.w);
                    *(u32x4*)(AH + (size_t)row * DM + col0 + bj * 128) = w;
                }
            }
            if (gsn) {
                ssq += __shfl_xor(ssq, 16); ssq += __shfl_xor(ssq, 32);
                if (fq == 0) SS[(size_t)row * 16 + u.pn * 4 + wc] = ssq;
            }
        }
#undef RES_LOAD
    }
    __device__ __forceinline__ void operator()(const f32x4 (&acc)[2][2][4][2], const Unit& u, int wr, int wc, int fr, int fq) const {
        if (xin_bf) body<false>(acc, u, wr, wc, fr, fq); else body<true>(acc, u, wr, wc, fr, fq);
    }
};

struct EpiInA {
    static constexpr bool PERM = false;
    const float* SS; const float* bias; const float* qkg; const float* rope; bf16_t* Q; bf16_t* KB; bf16_t* VB; bf16_t* P;
    __device__ __forceinline__ void operator()(const f32x4 (&acc)[2][2][4][2], const Unit& u, int wr, int wc, int fr, int fq) const {
        const int mi = mod_index_of_tile(u.pm);
        const int row0 = u.pm * 256 + wr * 64 + fr;
        float rsv[2][4]; row_rstd16x8(SS, row0, fq, rsv);
        asm volatile("" : "+v"(rsv[0][0]), "+v"(rsv[0][1]), "+v"(rsv[0][2]), "+v"(rsv[0][3]), "+v"(rsv[1][0]), "+v"(rsv[1][1]), "+v"(rsv[1][2]), "+v"(rsv[1][3]) :: "memory");
        const float* bp = bias + (size_t)mi * NFF + u.pn * 256 + wc * 32 + 4 * fq;
        f32x4 bv[2][2];
#pragma unroll
        for (int bj = 0; bj < 2; ++bj)
#pragma unroll
            for (int n = 0; n < 2; ++n) bv[bj][n] = *(const f32x4*)(bp + bj * 128 + 16 * n);
        if (u.pn >= 3) {
#pragma unroll
            for (int ai = 0; ai < 2; ++ai)
#pragma unroll
                for (int m = 0; m < 4; ++m) {
                    const int row = row0 + ai * 128 + m * 16;
                    const float rs = rsv[ai][m];
                    bf16_t* pp = P + (size_t)row * 512 + (u.pn - 3) * 256 + wc * 32 + 4 * fq;
#pragma unroll
                    for (int bj = 0; bj < 2; ++bj)
#pragma unroll
                        for (int n = 0; n < 2; ++n) { const f32x4 v = acc[ai][bj][m][n] * rs + bv[bj][n]; u32x2 w; w.x = cvt_pk_bf16(v.x, v.y); w.y = cvt_pk_bf16(v.z, v.w); *(u32x2*)(pp + bj * 128 + 16 * n) = w; }
                }
            return;
        }
        const bool isv = (u.pn == 2 && wc >= 2), isk = (u.pn == 2 && wc < 2);
        const int head = (u.pn < 2) ? (u.pn * 4 + wc) : (wc & 1);
        f32x4 gq[2][2];
#pragma unroll
        for (int bj = 0; bj < 2; ++bj)
#pragma unroll
            for (int n = 0; n < 2; ++n) gq[bj][n] = *(const f32x4*)(qkg + (isk ? 64 : 0) + 32 * bj + 16 * n + 4 * fq);
#pragma unroll
        for (int ai = 0; ai < 2; ++ai)
#pragma unroll
            for (int m = 0; m < 4; ++m) {
                const int row = row0 + ai * 128 + m * 16;
                const float rs = rsv[ai][m];
                f32x4 v[2][2];
#pragma unroll
                for (int bj = 0; bj < 2; ++bj)
#pragma unroll
                    for (int n = 0; n < 2; ++n) v[bj][n] = acc[ai][bj][m][n] * rs + bv[bj][n];
                const bool lat = row < ML;
                const int kvb = lat ? (row >> 13) : ((row - ML) >> 8), kvi = lat ? (CTXL + (row & 8191)) : ((row - ML) & 255);
                if (!isv) {
                    float ss = 0.f;
#pragma unroll
                    for (int bj = 0; bj < 2; ++bj)
#pragma unroll
                        for (int n = 0; n < 2; ++n) ss += (v[bj][n].x * v[bj][n].x + v[bj][n].y * v[bj][n].y) + (v[bj][n].z * v[bj][n].z + v[bj][n].w * v[bj][n].w);
                    ss += __shfl_xor(ss, 16); ss += __shfl_xor(ss, 32);
                    const float r = 1.0f / sqrtf(ss * (1.0f / 64.0f) + EPS);
#pragma unroll
                    for (int bj = 0; bj < 2; ++bj)
#pragma unroll
                        for (int n = 0; n < 2; ++n) v[bj][n] = v[bj][n] * r * gq[bj][n];
                    if (lat) {
                        const int t = row & 8191;
#pragma unroll
                        for (int bj = 0; bj < 2; ++bj) {
                            const int pos = bj == 0 ? (t >> 6) : (t & 63);
                            const f32x4 cs0 = *(const f32x4*)(rope + (size_t)pos * 32 + 8 * fq), cs1 = *(const f32x4*)(rope + (size_t)pos * 32 + 8 * fq + 4);
                            const f32x4 c = (f32x4){cs0.x, cs0.z, cs1.x, cs1.z}, s = (f32x4){cs0.y, cs0.w, cs1.y, cs1.w};
                            const f32x4 x1 = v[bj][0], x2 = v[bj][1];
                            v[bj][0] = x1 * c - x2 * s; v[bj][1] = x1 * s + x2 * c;
                        }
                    }
                    if (!isk) {
#pragma unroll
                        for (int bj = 0; bj < 2; ++bj)
#pragma unroll
                            for (int n = 0; n < 2; ++n) v[bj][n] = v[bj][n] * QSCALE;
                    }
                }
                bf16_t* dst = (u.pn < 2) ? (Q + (size_t)row * 512 + head * 64) : ((isk ? KB : VB) + ((size_t)(kvb * 2 + head) * KVROWS + kvi) * 64);
                dst += 4 * fq;
#pragma unroll
                for (int bj = 0; bj < 2; ++bj)
#pragma unroll
                    for (int n = 0; n < 2; ++n) { u32x2 w; w.x = cvt_pk_bf16(v[bj][n].x, v[bj][n].y); w.y = cvt_pk_bf16(v[bj][n].z, v[bj][n].w); *(u32x2*)(dst + 32 * bj + 16 * n) = w; }
            }
    }
};

struct EpiInC {
    static constexpr bool PERM = true;
    const float* SS; const float* bias; bf16_t* U; bf16_t* V; float* VSS;
    __device__ __forceinline__ void operator()(const f32x4 (&acc)[2][2][4][2], const Unit& u, int wr, int wc, int fr, int fq) const {
        const int mi = mod_index_of_tile(u.pm);
        const float* bp = bias + (size_t)mi * NFF + u.pn * 256 + wc * 32 + 8 * fq;
        f32x4 bv[2][2];
#pragma unroll
        for (int bj = 0; bj < 2; ++bj)
#pragma unroll
            for (int n = 0; n < 2; ++n) bv[bj][n] = *(const f32x4*)(bp + bj * 128 + 4 * n);
        const int row0 = u.pm * 256 + wr * 64 + fr;
        const bool isv = u.pn >= 4;
        bf16_t* base = isv ? V : U;
        const int ctile = (u.pn & 3) * 256 + wc * 32 + 8 * fq;
        float rsv[2][4]; row_rstd16x8(SS, row0, fq, rsv);
#pragma unroll
        for (int ai = 0; ai < 2; ++ai)
#pragma unroll
            for (int m = 0; m < 4; ++m) {
                const int row = row0 + ai * 128 + m * 16;
                const float rs = rsv[ai][m];
                float ssq = 0.f;
#pragma unroll
                for (int bj = 0; bj < 2; ++bj) {
                    float z[8];
#pragma unroll
                    for (int n = 0; n < 2; ++n)
#pragma unroll
                        for (int j = 0; j < 4; ++j) { z[n * 4 + j] = gelu_tanh_f(acc[ai][bj][m][n][j] * rs + bv[bj][n][j]); ssq += z[n * 4 + j] * z[n * 4 + j]; }
                    u32x4 w; w.x = cvt_pk_bf16(z[0], z[1]); w.y = cvt_pk_bf16(z[2], z[3]); w.z = cvt_pk_bf16(z[4], z[5]); w.w = cvt_pk_bf16(z[6], z[7]);
                    *(u32x4*)(base + (size_t)row * DM + ctile + bj * 128) = w;
                }
                if (isv) {
                    ssq += __shfl_xor(ssq, 16); ssq += __shfl_xor(ssq, 32);
                    if (fq == 0) VSS[(size_t)row * 16 + (u.pn - 4) * 4 + wc] = ssq;
                }
            }
    }
};
}

namespace attn_body {
using bf16 = __hip_bfloat16;
using s16x4 = __attribute__((ext_vector_type(4))) short;
using f32x16 = __attribute__((ext_vector_type(16))) float;
constexpr int D = 64, NW = 8, QBLK = 32, QB = QBLK * NW, KVBLK = 64;
constexpr int QP = 512, KVP = 64, OP = 1024;
__device__ __forceinline__ int crow(int r, int hi) { return (r & 3) + 8 * (r >> 2) + 4 * hi; }
#define SBAR() __builtin_amdgcn_sched_barrier(0)
constexpr int NSLOT = 3, SLOTB = 8192;
constexpr int LDS_K = 0, LDS_V = NSLOT * SLOTB, LDS_WS = 2 * NSLOT * SLOTB, LDS_OST = LDS_WS + NW * 64 * 4, LDS_BYTES_A = LDS_OST + NW * 4096;
__device__ __forceinline__ void glds16(const void* gsrc, unsigned lds_dst) { unsigned keep;
    asm volatile("s_mov_b32 %0, m0\n\ts_mov_b32 m0, %2\n\ts_nop 0\n\tglobal_load_lds_dwordx4 %1, off\n\ts_mov_b32 m0, %0" : "=&s"(keep) : "v"(gsrc), "s"(lds_dst) : "memory"); }
__device__ __forceinline__ float max3f(float a, float b, float c) { float r; asm("v_max3_f32 %0, %1, %2, %3" : "=v"(r) : "v"(a), "v"(b), "v"(c)); return r; }
__device__ __forceinline__ float max2f(float a, float b) { float r; asm("v_max_f32_e32 %0, %1, %2" : "=v"(r) : "v"(a), "v"(b)); return r; }
__device__ __forceinline__ float fadd_s(float a, float b) { float r; asm("v_add_f32_e32 %0, %1, %2" : "=v"(r) : "v"(a), "v"(b)); return r; }
__device__ __forceinline__ float fsub_s(float a, float b) { float r; asm("v_sub_f32_e32 %0, %1, %2" : "=v"(r) : "v"(a), "v"(b)); return r; }
typedef float f32x2_t __attribute__((ext_vector_type(2))); typedef __bf16 bf16x2_t __attribute__((ext_vector_type(2)));
__device__ __forceinline__ unsigned cvtpk_s(float lo, float hi) { f32x2_t v = {lo, hi}; bf16x2_t b = __builtin_convertvector(v, bf16x2_t); return __builtin_bit_cast(unsigned, b); }
#define WAIT_BAR(N) asm volatile("s_waitcnt vmcnt(" #N ") lgkmcnt(0)\n\ts_barrier" ::: "memory")
__device__ __forceinline__ void qkt(f32x16& p0, f32x16& p1, const char* Kslot, const bf16x8* qr, const f32x16& negm, int r32, int hi) {
    const char* kb = Kslot + hi * 1024 + r32 * 16;
#pragma unroll
    for (int d0 = 0; d0 < 4; ++d0) {
        const bf16x8 b0 = *reinterpret_cast<const bf16x8*>(kb + d0 * 2048);
        const bf16x8 b1 = *reinterpret_cast<const bf16x8*>(kb + d0 * 2048 + 512);
        if (d0 == 0) { p0 = __builtin_amdgcn_mfma_f32_32x32x16_bf16(b0, qr[0], negm, 0, 0, 0); p1 = __builtin_amdgcn_mfma_f32_32x32x16_bf16(b1, qr[0], negm, 0, 0, 0); }
        else { p0 = __builtin_amdgcn_mfma_f32_32x32x16_bf16(b0, qr[d0], p0, 0, 0, 0); p1 = __builtin_amdgcn_mfma_f32_32x32x16_bf16(b1, qr[d0], p1, 0, 0, 0); } }
}
typedef __attribute__((address_space(3))) const char* lds_cptr;
typedef short v4i16_t __attribute__((ext_vector_type(4)));
__device__ __forceinline__ void kload8(bf16x8* kf, lds_cptr kp) {
    kf[0] = *(const LAS bf16x8*)(kp);        kf[1] = *(const LAS bf16x8*)(kp + 512);
    kf[2] = *(const LAS bf16x8*)(kp + 2048); kf[3] = *(const LAS bf16x8*)(kp + 2560);
    kf[4] = *(const LAS bf16x8*)(kp + 4096); kf[5] = *(const LAS bf16x8*)(kp + 4608);
    kf[6] = *(const LAS bf16x8*)(kp + 6144); kf[7] = *(const LAS bf16x8*)(kp + 6656);
}
__device__ __forceinline__ void kload2(bf16x8* kf, lds_cptr kp, int j) { kf[2 * j] = *(const LAS bf16x8*)(kp + j * 2048); kf[2 * j + 1] = *(const LAS bf16x8*)(kp + j * 2048 + 512); }
__device__ __forceinline__ s16x4 vtr(lds_cptr p) { return __builtin_bit_cast(s16x4, __builtin_amdgcn_ds_read_tr16_b64_v4i16((LAS v4i16_t*)p)); }
__device__ __forceinline__ float rowmax(const f32x16& p0, const f32x16& p1) {
    float a = max3f(p0[0], p0[1], p1[0]), b = max3f(p0[2], p0[3], p1[1]); a = max3f(a, p1[2], p1[3]);
#pragma unroll
    for (int r = 4; r < 16; r += 4) { a = max3f(a, p0[r], p0[r + 1]); b = max3f(b, p0[r + 2], p0[r + 3]); a = max3f(a, p1[r], p1[r + 1]); b = max3f(b, p1[r + 2], p1[r + 3]); }
    const float m = max2f(a, b);
    auto rr = __builtin_amdgcn_permlane32_swap(__float_as_uint(m), __float_as_uint(m), false, false);
    return max2f(__uint_as_float(rr[0]), __uint_as_float(rr[1]));
}
__device__ __forceinline__ void pv(f32x16* o, int vb, bf16x8 pa0, bf16x8 pa1, bf16x8 pa2, bf16x8 pa3) {
#pragma unroll
    for (int d0 = 0; d0 < 2; ++d0) { s16x4 lo[4], hi[4];
#pragma unroll
        for (int ks = 0; ks < 4; ++ks) {
            asm volatile("ds_read_b64_tr_b16 %0,%1 offset:%c2" : "=&v"(lo[ks]) : "v"(vb), "i"(d0 * 4096 + ks * 1024) : "memory");
            asm volatile("ds_read_b64_tr_b16 %0,%1 offset:%c2" : "=&v"(hi[ks]) : "v"(vb), "i"(d0 * 4096 + ks * 1024 + 512) : "memory"); }
        asm volatile("s_waitcnt lgkmcnt(0)" ::: "memory"); SBAR();
#define PK(k) (bf16x8){lo[k][0], lo[k][1], lo[k][2], lo[k][3], hi[k][0], hi[k][1], hi[k][2], hi[k][3]}
        o[d0] = __builtin_amdgcn_mfma_f32_32x32x16_bf16(pa0, PK(0), o[d0], 0, 0, 0);
        o[d0] = __builtin_amdgcn_mfma_f32_32x32x16_bf16(pa1, PK(1), o[d0], 0, 0, 0);
        o[d0] = __builtin_amdgcn_mfma_f32_32x32x16_bf16(pa2, PK(2), o[d0], 0, 0, 0);
        o[d0] = __builtin_amdgcn_mfma_f32_32x32x16_bf16(pa3, PK(3), o[d0], 0, 0, 0);
#undef PK
    }
}

template <int THRL> __device__ __forceinline__ void attn_unit(const bf16* Qu, const bf16* __restrict__ Kh, const bf16* __restrict__ Vh, const int NT, bf16* Ou, char* shm) {
    int tid_ = threadIdx.x; asm volatile("" : "+v"(tid_));
    const int tid = tid_, lane = tid & 63, r32 = lane & 31, hi = lane >> 5; const int wid = __builtin_amdgcn_readfirstlane(tid >> 6);
    const bf16* Qw = Qu + (long)(wid * QBLK) * QP;
    const unsigned lds0 = (unsigned)(uintptr_t)shm;
    float* wsf = (float*)(shm + LDS_WS) + wid * 64;
    const bf16* ksrc = Kh + (long)lane * KVP + wid * 8;
    const bf16* vsrc = Vh + (long)(16 * (wid & 3) + (lane >> 2)) * KVP + (wid >> 2) * 32 + (lane & 3) * 8;
    const unsigned kdst = lds0 + LDS_K + wid * 1024, vdst = lds0 + LDS_V + wid * 1024;
#define DMA_K(t, slot) glds16(ksrc + (long)(t) * KVBLK * KVP, (unsigned)__builtin_amdgcn_readfirstlane(kdst + (slot)))
#define DMA_V(t, slot) glds16(vsrc + (long)(t) * KVBLK * KVP, (unsigned)__builtin_amdgcn_readfirstlane(vdst + (slot)))
    const int vb0 = (int)(lds0 + LDS_V) + ((lane >> 4) & 1) * 32 + (lane & 3) * 8 + (4 * hi + ((lane & 15) >> 2)) * 64;
    const char* Kbase = shm + LDS_K; bf16x8 kf[8];
    const lds_cptr shm3 = (lds_cptr)shm; const lds_cptr kp0 = shm3 + LDS_K + hi * 1024 + r32 * 16; const lds_cptr vp0 = shm3 + LDS_V + ((lane >> 4) & 1) * 32 + (lane & 3) * 8 + (4 * hi + ((lane & 15) >> 2)) * 64;
    DMA_K(0, 0); DMA_V(0, 0); DMA_K(1, SLOTB);
    bf16x8 qr[4];
#pragma unroll
    for (int d0 = 0; d0 < 4; ++d0) qr[d0] = *reinterpret_cast<const bf16x8*>(&Qw[(long)r32 * QP + d0 * 16 + hi * 8]);
    float mhat = 0.f, l_reg = 0.f; f32x16 o[2]; o[0] = f32x16{}; o[1] = f32x16{}; f32x16 negm = f32x16{}; asm volatile("" : "+v"(negm));
    bool resc = false;
#define START(P0, P1) do { const float rm = rowmax(P0, P1); resc = false; \
    { const float dl = rm; mhat = fadd_s(mhat, dl); \
      _Pragma("unroll") for (int r = 0; r < 16; ++r) { P0[r] = fsub_s(P0[r], dl); P1[r] = fsub_s(P1[r], dl); } \
      _Pragma("unroll") for (int r = 0; r < 16; ++r) negm[r] = -mhat; asm volatile("" : "+v"(negm)); } \
    _Pragma("unroll") for (int r = 0; r < 16; ++r) P0[r] = __builtin_amdgcn_exp2f(P0[r]); } while (0)
#define RESC() do { if (resc) { asm volatile("s_waitcnt lgkmcnt(0)" ::: "memory"); \
      _Pragma("unroll") for (int d_ = 0; d_ < 2; ++d_) _Pragma("unroll") for (int r = 0; r < 16; ++r) o[d_][r] *= wsf[crow(r, hi)]; } } while (0)
    f32x16 pA0, pA1, pB0, pB1;
    int sl_prev = 0, sl_cur = 0, sl_next = SLOTB;
#define ROT() do { sl_prev = sl_cur; sl_cur = sl_next; sl_next = (sl_next == (NSLOT - 1) * SLOTB) ? 0 : sl_next + SLOTB; } while (0)
    DMA_K(2, 2 * SLOTB);
    WAIT_BAR(3);
    qkt(pA0, pA1, Kbase, qr, negm, r32, hi); asm volatile("s_nop 15\n\ts_nop 7" : "+v"(pA0), "+v"(pA1));
    START(pA0, pA1);
    _Pragma("unroll") for (int r = 0; r < 16; ++r) pA1[r] = __builtin_amdgcn_exp2f(pA1[r]);
    WAIT_BAR(0);
    DMA_K(3, 0); DMA_V(1, SLOTB);
    ROT();
    kload8(kf, kp0 + sl_cur);
    WAIT_BAR(2);
    s16x4 vlo[8], vhi[8]; u32x4 pw0, pw1, pw2, pw3;
#define PKW(P, B) cvtpk_s(P[B], P[B + 1])
#define PAF(k) __builtin_bit_cast(bf16x8, pw##k)
#define VFR(i) (bf16x8){vlo[i][0], vlo[i][1], vlo[i][2], vlo[i][3], vhi[i][0], vhi[i][1], vhi[i][2], vhi[i][3]}
#define PIN(x) asm volatile("" : "+v"(x))
#define MX3(a, b, c) __builtin_fmaxf(__builtin_fmaxf((a), (b)), (c))
#define GAPA(MF, A0, A1, A2, A3, W0, W1, PW) do { MF; sacc += A0; sacc += A1; sacc += A2; sacc += A3; PIN(sacc); W0; W1; PIN(PW); SBAR(); } while (0)
#define EX(v) __builtin_amdgcn_exp2f(v)
#define GAPB(MF, X, B) do { MF; X[B] = EX(X[B]); X[B + 1] = EX(X[B + 1]); X[B + 2] = EX(X[B + 2]); X[B + 3] = EX(X[B + 3]); PIN(X); SBAR(); } while (0)
#define VRD(i) do { vlo[i] = vtr(vp_ + (((i) >> 2) * 4096 + ((i) & 3) * 1024)); vhi[i] = vtr(vp_ + (((i) >> 2) * 4096 + ((i) & 3) * 1024 + 512)); } while (0)
#define KRD(G, j) do { if (G) { kload2(kf, kp0 + sl_next, j); SBAR(); } } while (0)
#define STEP(C0, C1, P0, P1, t, GK, GV, GL) do { SBAR(); \
    const lds_cptr vp_ = vp0 + sl_prev; \
    VRD(0); SBAR(); float sacc = (P0[0] + P0[1]); \
    GAPA(C0 = __builtin_amdgcn_mfma_f32_32x32x16_bf16(kf[0], qr[0], negm, 0, 0, 0), P0[2], P0[3], P0[4], P0[5],     pw0[0] = PKW(P0, 0), pw0[1] = PKW(P0, 2), pw0); \
    VRD(4); SBAR(); GAPA(C1 = __builtin_amdgcn_mfma_f32_32x32x16_bf16(kf[1], qr[0], negm, 0, 0, 0), P0[6], P0[7], P0[8], P0[9],     pw0[2] = PKW(P0, 4), pw0[3] = PKW(P0, 6), pw0); \
    VRD(1); SBAR(); GAPA(C0 = __builtin_amdgcn_mfma_f32_32x32x16_bf16(kf[2], qr[1], C0, 0, 0, 0),   P0[10], P0[11], P0[12], P0[13], pw1[0] = PKW(P0, 8), pw1[1] = PKW(P0, 10), pw1); \
    VRD(5); SBAR(); GAPA(C1 = __builtin_amdgcn_mfma_f32_32x32x16_bf16(kf[3], qr[1], C1, 0, 0, 0),   P0[14], P0[15], P1[0], P1[1],   pw1[2] = PKW(P0, 12), pw1[3] = PKW(P0, 14), pw1); \
    VRD(2); SBAR(); GAPA(C0 = __builtin_amdgcn_mfma_f32_32x32x16_bf16(kf[4], qr[2], C0, 0, 0, 0),   P1[2], P1[3], P1[4], P1[5],     pw2[0] = PKW(P1, 0), pw2[1] = PKW(P1, 2), pw2); \
    VRD(6); SBAR(); GAPA(C1 = __builtin_amdgcn_mfma_f32_32x32x16_bf16(kf[5], qr[2], C1, 0, 0, 0),   P1[6], P1[7], P1[8], P1[9],     pw2[2] = PKW(P1, 4), pw2[3] = PKW(P1, 6), pw2); \
    VRD(3); SBAR(); GAPA(C0 = __builtin_amdgcn_mfma_f32_32x32x16_bf16(kf[6], qr[3], C0, 0, 0, 0),   P1[10], P1[11], P1[12], P1[13], pw3[0] = PKW(P1, 8), pw3[1] = PKW(P1, 10), pw3); \
    VRD(7); SBAR(); GAPA(C1 = __builtin_amdgcn_mfma_f32_32x32x16_bf16(kf[7], qr[3], C1, 0, 0, 0),   P1[14], P1[15], 0.f, 0.f,       pw3[2] = PKW(P1, 12), pw3[3] = PKW(P1, 14), pw3); \
    l_reg += sacc; \
    if (GK) { DMA_K((t) + 3, sl_cur); } if (GV) { DMA_V((t) + 1, sl_next); } \
    { float a = MX3(C0[0], C0[1], C1[0]), b = MX3(C0[2], C0[3], C1[1]); a = MX3(a, C1[2], C1[3]); \
      _Pragma("unroll") for (int r = 4; r < 16; r += 4) { a = MX3(a, C0[r], C0[r + 1]); b = MX3(b, C0[r + 2], C0[r + 3]); a = MX3(a, C1[r], C1[r + 1]); b = MX3(b, C1[r + 2], C1[r + 3]); } \
      float rm = __builtin_fmaxf(a, b); { auto rr = __builtin_amdgcn_permlane32_swap(__float_as_uint(rm), __float_as_uint(rm), false, false); rm = __builtin_fmaxf(__uint_as_float(rr[0]), __uint_as_float(rr[1])); } \
      resc = false; \
      if (__builtin_expect(__any(rm > (float)THRL), 0)) { const float dl = __builtin_fmaxf(rm, 0.f); mhat += dl; \
        _Pragma("unroll") for (int r = 0; r < 16; ++r) { C0[r] -= dl; C1[r] -= dl; } \
        _Pragma("unroll") for (int r = 0; r < 16; ++r) negm[r] = -mhat; asm volatile("" : "+v"(negm)); \
        const float f = __builtin_amdgcn_exp2f(-dl); l_reg *= f; if (hi == 0) wsf[r32] = f; resc = true; } } \
    SBAR(); \
    GAPB(o[0] = __builtin_amdgcn_mfma_f32_32x32x16_bf16(PAF(0), VFR(0), o[0], 0, 0, 0), C0, 0); \
    GAPB(o[1] = __builtin_amdgcn_mfma_f32_32x32x16_bf16(PAF(0), VFR(4), o[1], 0, 0, 0), C0, 4); \
    KRD(GL, 0); GAPB(o[0] = __builtin_amdgcn_mfma_f32_32x32x16_bf16(PAF(1), VFR(1), o[0], 0, 0, 0), C0, 8); \
    KRD(GL, 1); GAPB(o[1] = __builtin_amdgcn_mfma_f32_32x32x16_bf16(PAF(1), VFR(5), o[1], 0, 0, 0), C0, 12); \
    KRD(GL, 2); GAPB(o[0] = __builtin_amdgcn_mfma_f32_32x32x16_bf16(PAF(2), VFR(2), o[0], 0, 0, 0), C1, 0); \
    KRD(GL, 3); GAPB(o[1] = __builtin_amdgcn_mfma_f32_32x32x16_bf16(PAF(2), VFR(6), o[1], 0, 0, 0), C1, 4); \
    GAPB(o[0] = __builtin_amdgcn_mfma_f32_32x32x16_bf16(PAF(3), VFR(3), o[0], 0, 0, 0), C1, 8); \
    GAPB(o[1] = __builtin_amdgcn_mfma_f32_32x32x16_bf16(PAF(3), VFR(7), o[1], 0, 0, 0), C1, 12); \
    } while (0)
    int t = 1;
    for (; t + 5 < NT; t += 2) {
        STEP(pB0, pB1, pA0, pA1, t, true, true, true);     WAIT_BAR(2); RESC(); ROT();
        STEP(pA0, pA1, pB0, pB1, t + 1, true, true, true); WAIT_BAR(2); RESC(); ROT();
    }
#define ENDW(tt) do { if ((tt) + 3 < NT) { WAIT_BAR(2); } else if ((tt) + 2 < NT) { WAIT_BAR(1); } else { WAIT_BAR(0); } } while (0)
    for (; t + 1 < NT; t += 2) {
        STEP(pB0, pB1, pA0, pA1, t, (t + 3 < NT), (t + 1 < NT), (t + 1 < NT));       ENDW(t);     RESC(); ROT();
        STEP(pA0, pA1, pB0, pB1, t + 1, (t + 4 < NT), (t + 2 < NT), (t + 2 < NT));   ENDW(t + 1); RESC(); ROT();
    }
    STEP(pB0, pB1, pA0, pA1, NT - 1, false, false, false); RESC();
    { float sacc = pB0[0] + pB0[1]; _Pragma("unroll") for (int r = 2; r < 16; ++r) sacc += pB0[r]; _Pragma("unroll") for (int r = 0; r < 16; ++r) sacc += pB1[r]; l_reg += sacc;
      pw0 = (u32x4){PKW(pB0, 0), PKW(pB0, 2), PKW(pB0, 4), PKW(pB0, 6)}; pw1 = (u32x4){PKW(pB0, 8), PKW(pB0, 10), PKW(pB0, 12), PKW(pB0, 14)}; pw2 = (u32x4){PKW(pB1, 0), PKW(pB1, 2), PKW(pB1, 4), PKW(pB1, 6)}; pw3 = (u32x4){PKW(pB1, 8), PKW(pB1, 10), PKW(pB1, 12), PKW(pB1, 14)};
      SBAR(); pv(o, vb0 + sl_cur, PAF(0), PAF(1), PAF(2), PAF(3)); }
#undef PKW
#undef PAF
#undef VFR
#undef PIN
#undef MX3
#undef GAPA
#undef GAPB
#undef EX
#undef VRD
#undef KRD
#undef STEP
#undef ENDW
    { auto rr = __builtin_amdgcn_permlane32_swap(__float_as_uint(l_reg), __float_as_uint(l_reg), false, false); l_reg = __uint_as_float(rr[0]) + __uint_as_float(rr[1]); }
    if (hi == 0) wsf[32 + r32] = l_reg; asm volatile("s_waitcnt lgkmcnt(0)" ::: "memory");
    float rli[16];
#pragma unroll
    for (int r = 0; r < 16; ++r) rli[r] = __builtin_amdgcn_rcpf(wsf[32 + crow(r, hi)]);
    bf16* Ow = Ou + (long)(wid * QBLK) * OP;
    { bf16* stg = (bf16*)(shm + LDS_OST) + wid * 2048;
#pragma unroll
      for (int r = 0; r < 16; ++r) { const int orow = crow(r, hi);
#pragma unroll
        for (int d0 = 0; d0 < 2; ++d0) stg[orow * 64 + d0 * 32 + r32] = __float2bfloat16(o[d0][r] * rli[r]); }
      asm volatile("s_waitcnt lgkmcnt(0)" ::: "memory");
#pragma unroll
      for (int i = 0; i < 4; ++i) { const int row = i * 8 + (lane >> 3), ch = lane & 7; const u32x4 v = *(const u32x4*)(stg + row * 64 + ch * 8); *(u32x4*)(Ow + (long)row * OP + ch * 8) = v; } }
    asm volatile("s_waitcnt lgkmcnt(0)\n\ts_barrier" ::: "memory");
#undef DMA_K
#undef DMA_V
#undef START
#undef RESC
#undef ROT
}
#undef SBAR
#undef WAIT_BAR
}

template <int KS> __device__ __forceinline__ void ctx_gemm_resid(LAS unsigned char* lds, const bf16_t* A, const bf16_t* Wt, const pg8::EpiResid& E, int tile) {
    int tid_ = threadIdx.x; asm volatile("" : "+v"(tid_));
    const int tid = tid_, lane = tid & 63, wave = __builtin_amdgcn_readfirstlane(tid >> 6), fr = lane & 15, fq = lane >> 4;
    constexpr int K = KS * 256;
    const int rt = tile >> 4, ct = tile & 15, row0 = ML + rt * 32, col0 = ct * 64;
    const bf16_t* ap = A + (size_t)(row0 + fr) * K + wave * (KS * 32) + 8 * fq;
    const bf16_t* bp = Wt + (size_t)(col0 + fr) * K + wave * (KS * 32) + 8 * fq;
    const int erow = row0 + (tid >> 4), ecol = col0 + 4 * (tid & 15);
    const f32x4 e_gate = *(const f32x4*)(E.gate + (size_t)2 * NMOD + ecol);
    f32x4 e_x;
    if (E.xin_bf) { const u32x2 w = *(const u32x2*)(E.xin_bf + (size_t)erow * DM + ecol); const f32x2 p0 = unpk_h2(w.x), p1 = unpk_h2(w.y); e_x = (f32x4){p0.x, p0.y, p1.x, p1.y}; }
    else e_x = *(const f32x4*)(E.xin_ctx + (size_t)(erow - ML) * DM + ecol);
    const f32x4 e_gs = E.gsn ? *(const f32x4*)(E.gsn + (size_t)2 * DM + ecol) : (f32x4){0.f, 0.f, 0.f, 0.f};
    f32x4 acc[2][4];
#pragma unroll
    for (int rb = 0; rb < 2; ++rb)
#pragma unroll
        for (int cb = 0; cb < 4; ++cb) acc[rb][cb] = (f32x4){0.f, 0.f, 0.f, 0.f};
    constexpr int CH = (KS >= 6) ? 3 : 2, NCH = (KS + CH - 1) / CH;
    bf16x8 fa[2][CH][2], fb[2][CH][4];
#define CTX_LOAD(c, buf) do { _Pragma("unroll") for (int q = 0; q < CH; ++q) if ((c) * CH + q < KS) { \
        _Pragma("unroll") for (int rb = 0; rb < 2; ++rb) fa[buf][q][rb] = *(const bf16x8*)(ap + (size_t)(16 * rb) * K + 32 * ((c) * CH + q)); \
        _Pragma("unroll") for (int cb = 0; cb < 4; ++cb) fb[buf][q][cb] = *(const bf16x8*)(bp + (size_t)(16 * cb) * K + 32 * ((c) * CH + q)); } } while (0)
    CTX_LOAD(0, 0);
#pragma unroll
    for (int c = 0; c < NCH; ++c) {
        __builtin_amdgcn_sched_barrier(0);
        if (c + 1 < NCH) CTX_LOAD(c + 1, (c + 1) & 1);
        __builtin_amdgcn_sched_barrier(0);
#pragma unroll
        for (int q = 0; q < CH; ++q) if (c * CH + q < KS) {
#pragma unroll
            for (int rb = 0; rb < 2; ++rb)
#pragma unroll
                for (int cb = 0; cb < 4; ++cb) acc[rb][cb] = __builtin_amdgcn_mfma_f32_16x16x32_bf16(fb[c & 1][q][cb], fa[c & 1][q][rb], acc[rb][cb], 0, 0, 0);
        }
    }
    __builtin_amdgcn_sched_barrier(0);
#undef CTX_LOAD
    LAS float* red = (LAS float*)lds;
#pragma unroll
    for (int rb = 0; rb < 2; ++rb)
#pragma unroll
        for (int cb = 0; cb < 4; ++cb) *(LAS f32x4*)(red + ((wave * 8 + rb * 4 + cb) * 64 + lane) * 4) = acc[rb][cb];
    __syncthreads();
    {
        const int r = tid >> 4, c4 = tid & 15, rb = r >> 4, j = r & 15, cb = c4 >> 2, q = c4 & 3, ln = q * 16 + j;
        f32x4 sum = (f32x4){0.f, 0.f, 0.f, 0.f};
#pragma unroll
        for (int w = 0; w < 8; ++w) sum += *(const LAS f32x4*)(red + ((w * 8 + rb * 4 + cb) * 64 + ln) * 4);
        const int row = erow, col = ecol;
        const f32x4 y = e_x + (e_gate * E.fac) * sum;
        { u32x2 w; w.x = pk_h2(y.x, y.y); w.y = pk_h2(y.z, y.w); *(u32x2*)(E.xout_bf + (size_t)row * DM + col) = w; }
        if (E.gsn) {
            const f32x4 av = y * e_gs;
            u32x2 w; w.x = cvt_pk_bf16(av.x, av.y); w.y = cvt_pk_bf16(av.z, av.w);
            *(u32x2*)(E.AH + (size_t)row * DM + col) = w;
            float ssq = (y.x * y.x + y.y * y.y) + (y.z * y.z + y.w * y.w);
            ssq += __shfl_xor(ssq, 1); ssq += __shfl_xor(ssq, 2); ssq += __shfl_xor(ssq, 4); ssq += __shfl_xor(ssq, 8);
            if (c4 == 0) E.SS[(size_t)row * 16 + ct] = ssq;
        }
    }
    __syncthreads();
}

#define XB_TMO      128
#define XB_XCNT(j)  (256  + 64 * (j))
#define XB_XSUB(j)  (1280 + 64 * (j))
#define XB_XGEN(j)  (2304 + 64 * (j))
#define XB_TOP      3328
#define XB_TOPGEN   3392
#define XCD_BAR_WORDS 3456
#define XB_SPIN_CAP (1u << 20)
__device__ __forceinline__ unsigned xb_ld(unsigned* p)              { return __hip_atomic_load(p, __ATOMIC_RELAXED, __HIP_MEMORY_SCOPE_AGENT); }
__device__ __forceinline__ unsigned xb_add(unsigned* p, unsigned v) { return __hip_atomic_fetch_add(p, v, __ATOMIC_RELAXED, __HIP_MEMORY_SCOPE_AGENT); }
__device__ __forceinline__ unsigned xb_xcc_id() { return (unsigned)__builtin_amdgcn_s_getreg((3 << 11) | 20) & 0xFu; }
#define XB_SPIN(cond, bar) do { unsigned _sp = 0; while (cond) { __builtin_amdgcn_s_sleep(1); \
    if ((++_sp & 255u) == 0u) { if (xb_ld(&(bar)[XB_TMO])) break; if (_sp > XB_SPIN_CAP) { atomicAdd(&(bar)[XB_TMO], 1u); break; } } } } while (0)
struct XcdBarrier { unsigned* bar; unsigned x; volatile LAS unsigned* st; };
__device__ __forceinline__ XcdBarrier xcd_barrier_post(unsigned* bar, volatile LAS unsigned* st) {
    XcdBarrier b; b.bar = bar; b.x = xb_xcc_id(); b.st = st;
    if (threadIdx.x == 0) (void)xb_add(&bar[XB_XCNT(b.x)], 1u);
    return b;
}
__device__ __forceinline__ void xcd_barrier_complete(unsigned* bar, unsigned x, unsigned& nloc, unsigned& nx) {
    const unsigned G = gridDim.x * gridDim.y * gridDim.z;
    unsigned sum, cnt, mine, sp = 0u;
    for (;;) {
        sum = 0u; cnt = 0u; mine = 0u;
#pragma unroll
        for (unsigned j = 0; j < 16; ++j) { const unsigned c = xb_ld(&bar[XB_XCNT(j)]); sum += c; cnt += (c > 0u) ? 1u : 0u; mine = (j == x) ? c : mine; }
        if (sum == G) break;
        __builtin_amdgcn_s_sleep(1);
        if ((++sp & 255u) == 0u) { if (xb_ld(&bar[XB_TMO])) break; if (sp > XB_SPIN_CAP) { atomicAdd(&bar[XB_TMO], 1u); break; } }
    }
    nloc = mine > 0u ? mine : 1u; nx = cnt > 0u ? cnt : 1u;
}
__device__ __forceinline__ void xcd_barrier(const XcdBarrier& b) {
    asm volatile("s_waitcnt vmcnt(0)" ::: "memory");
    __syncthreads();
    if (threadIdx.x == 0) {
        unsigned* bar = b.bar;
        __builtin_amdgcn_s_waitcnt(0);
        unsigned nloc = b.st[0], nx = b.st[1];
        if (nloc == 0u) { xcd_barrier_complete(bar, b.x, nloc, nx); b.st[0] = nloc; b.st[1] = nx; }
        const unsigned old = xb_add(&bar[XB_XSUB(b.x)], 1u);
        const unsigned gen = old / nloc;
        if (old + 1u == (gen + 1u) * nloc) {
            __builtin_amdgcn_fence(__ATOMIC_RELEASE, "agent");
            asm volatile("s_waitcnt vmcnt(0)" ::: "memory");
            const unsigned og = xb_add(&bar[XB_TOP], 1u);
            const unsigned tg = og / nx;
            if (og + 1u == (tg + 1u) * nx) xb_add(&bar[XB_TOPGEN], 1u);
            else XB_SPIN(xb_ld(&bar[XB_TOPGEN]) == tg, bar);
            __builtin_amdgcn_fence(__ATOMIC_ACQUIRE, "agent");
            xb_add(&bar[XB_XGEN(b.x)], 1u);
            asm volatile("s_waitcnt vmcnt(0)" ::: "memory");
        } else {
            XB_SPIN(xb_ld(&bar[XB_XGEN(b.x)]) == gen, bar);
            __builtin_amdgcn_fence(__ATOMIC_ACQUIRE, "agent");
            asm volatile("s_waitcnt vmcnt(0)" ::: "memory");
        }
    }
    __syncthreads();
}

struct Args { const float* in[19]; float* out; unsigned char* ws; int ph_lo, ph_hi; };
enum { I_X = 0, I_C, I_CTX, I_CCTX, I_WMOD, I_BMOD, I_NORMG, I_W13, I_W2, I_WINA, I_QKG, I_POOLW, I_POOLS, I_WOUTA, I_WINC, I_VNG, I_WSP, I_BSP, I_WOUTC };

__device__ const float INVF[16] = {1.0f, 0.5623413324356079f, 0.3162277638912201f, 0.17782793939113617f, 0.10000000149011612f, 0.05623413249850273f, 0.03162277489900589f, 0.017782794311642647f,
    0.009999999776482582f, 0.005623413249850273f, 0.003162277629598975f, 0.0017782794311642647f, 0.0010000000474974513f, 0.000562341301701963f, 0.0003162277571391314f, 0.00017782794020604342f};

__device__ __forceinline__ void transpose_item(const float* W, int N, bf16_t* WT, int Kd, int k0, int n0, int dst_row0, LAS float* scr, int lane) {
    float tv[32];
#pragma unroll
    for (int i = 0; i < 32; ++i) { const int kk = 2 * i + (lane >> 5); tv[i] = W[(size_t)(k0 + kk) * N + n0 + (lane & 31)]; }
#pragma unroll
    for (int i = 0; i < 32; ++i) { const int kk = 2 * i + (lane >> 5); scr[kk * 33 + (lane & 31)] = tv[i]; }
    asm volatile("s_waitcnt lgkmcnt(0)" ::: "memory");
    const int c = lane & 7;
#pragma unroll
    for (int j = 0; j < 4; ++j) { const int n = (lane >> 3) + 8 * j; const LAS float* s = scr + (8 * c) * 33 + n;
        u32x4 o; o.x = cvt_pk_bf16(s[0 * 33], s[1 * 33]); o.y = cvt_pk_bf16(s[2 * 33], s[3 * 33]); o.z = cvt_pk_bf16(s[4 * 33], s[5 * 33]); o.w = cvt_pk_bf16(s[6 * 33], s[7 * 33]);
        *(u32x4*)(WT + (size_t)(dst_row0 + n) * Kd + k0 + 8 * c) = o; }
    asm volatile("s_waitcnt lgkmcnt(0)" ::: "memory");
}

__device__ __forceinline__ void convert_w13(const Args& a, LAS unsigned char* lds, int mx, int first, int nblk) {
    if ((int)blockIdx.x < first) return;
    int tid_ = threadIdx.x; asm volatile("" : "+v"(tid_));
    const int tid = tid_, lane = tid & 63, wave = __builtin_amdgcn_readfirstlane(tid >> 6);
    LAS float* scr = (LAS float*)(lds + wave * 16384);
    const int gw = ((int)blockIdx.x - first) * 8 + wave, NGW = nblk * 8;
    for (int r = gw; r < 16 * 176; r += NGW) {
        const int kb = r / 176, nb = r % 176, n0 = nb * 32, half = n0 / DFF, idx = n0 % DFF;
        transpose_item(a.in[I_W13] + (size_t)mx * DM * NFF, NFF, (bf16_t*)(a.ws + WS_W13 + (size_t)mx * SZ_W13), DM, kb * 64, n0, (idx >> 7) * 256 + half * 128 + (idx & 127), scr, lane);
    }
}

__device__ __forceinline__ void convert_w2(const Args& a, LAS unsigned char* lds, int mx, int first, int nblk) {
    if ((int)blockIdx.x < first) return;
    int tid_ = threadIdx.x; asm volatile("" : "+v"(tid_));
    const int tid = tid_, lane = tid & 63, wave = __builtin_amdgcn_readfirstlane(tid >> 6);
    LAS float* scr = (LAS float*)(lds + wave * 16384);
    const int gw = ((int)blockIdx.x - first) * 8 + wave, NGW = nblk * 8;
    for (int r = gw; r < 44 * 32; r += NGW) {
        const int kb = r / 32, nb = r % 32;
        transpose_item(a.in[I_W2] + (size_t)mx * DFF * DM, DM, (bf16_t*)(a.ws + WS_W2 + (size_t)mx * SZ_W2), DFF, kb * 64, nb * 32, nb * 32, scr, lane);
    }
}

__device__ __forceinline__ void phase_p0(const Args& a, LAS unsigned char* lds) {
    unsigned char* ws = a.ws;
    int tid_ = threadIdx.x; asm volatile("" : "+v"(tid_));
    const int tid = tid_, lane = tid & 63, wave = __builtin_amdgcn_readfirstlane(tid >> 6), G = gridDim.x;
    LAS float* sl = (LAS float*)(lds + LDS_SILU);
    for (int i = tid; i < 3 * DM; i += 512) { const float cv = (i < 2 * DM) ? a.in[I_C][i] : a.in[I_CCTX][i - 2 * DM]; sl[i] = cv / (1.0f + expf(-cv)); }
    {
        LAS float* scr = (LAS float*)(lds + wave * 16384);
        const int gw = blockIdx.x * 8 + wave, NGW = G * 8;
        constexpr int N13 = 16 * 176, N2 = 44 * 32, NINA = 16 * 40, NOUTA = 8 * 32, NINC = 16 * 64, NOUTC = 16 * 32;
        constexpr int T13 = 8 * N13, T2 = T13 + 8 * N2, TINA = T2 + 2 * NINA, TOUTA = TINA + 2 * NOUTA, TINC = TOUTA + 2 * NINC, TOUTC = TINC + 2 * NOUTC;
        for (int it0 = gw; it0 < TOUTC - 6 * N13; it0 += NGW) {
            const int it = it0 < 2 * N13 ? it0 : it0 + 6 * N13;
            if (it < T13) { const int mx = it / N13, r = it % N13, kb = r / 176, nb = r % 176, n0 = nb * 32, half = n0 / DFF, idx = n0 % DFF;
                if (mx >= 2) continue;
                transpose_item(a.in[I_W13] + (size_t)mx * DM * NFF, NFF, (bf16_t*)(ws + WS_W13 + mx * SZ_W13), DM, kb * 64, n0, (idx >> 7) * 256 + half * 128 + (idx & 127), scr, lane); }
            else if (it < T2) { const int q = it - T13, mx = q / N2, r = q % N2, kb = r / 32, nb = r % 32;
                if (mx >= 2) continue;
                transpose_item(a.in[I_W2] + (size_t)mx * DFF * DM, DM, (bf16_t*)(ws + WS_W2 + mx * SZ_W2), DFF, kb * 64, nb * 32, nb * 32, scr, lane); }
            else if (it < TINA) { const int q = it - T2, mx = q / NINA, r = q % NINA, kb = r / 40, nb = r % 40, n0 = nb * 32;
                int dst;
                if (n0 < 512) { const int head = n0 >> 6, d = n0 & 63; dst = (head >> 2) * 256 + (d >> 5) * 128 + (head & 3) * 32; }
                else if (n0 < 640) { const int head = (n0 - 512) >> 6, d = n0 & 63; dst = 512 + (d >> 5) * 128 + head * 32; }
                else if (n0 < 768) { const int head = (n0 - 640) >> 6, d = n0 & 63; dst = 512 + (d >> 5) * 128 + (2 + head) * 32; }
                else dst = n0;
                transpose_item(a.in[I_WINA] + (size_t)mx * DM * 1280, 1280, (bf16_t*)(ws + WS_WINA + mx * SZ_WINA), DM, kb * 64, n0, dst, scr, lane); }
            else if (it < TOUTA) { const int q = it - TINA, mx = q / NOUTA, r = q % NOUTA, kb = r / 32, nb = r % 32;
                transpose_item(a.in[I_WOUTA] + (size_t)mx * DM * DM, DM, (bf16_t*)(ws + WS_WOUTA + mx * SZ_WSQ), DM, kb * 64, nb * 32, nb * 32, scr, lane); }
            else if (it < TINC) { const int q = it - TOUTA, mx = q / NINC, r = q % NINC, kb = r / 64, nb = r % 64;
                transpose_item(a.in[I_WINC] + (size_t)mx * DM * 2048, 2048, (bf16_t*)(ws + WS_WINC + mx * SZ_WINC), DM, kb * 64, nb * 32, nb * 32, scr, lane); }
            else { const int q = it - TINC, mx = q / NOUTC, r = q % NOUTC, kb = r / 32, nb = r % 32;
                transpose_item(a.in[I_WOUTC] + (size_t)mx * DM * DM, DM, (bf16_t*)(ws + WS_WOUTC + mx * SZ_WSQ), DM, kb * 64, nb * 32, nb * 32, scr, lane); }
        }
    }
    __syncthreads();
    {
        LAS float* red = (LAS float*)lds;
        float* MOD = (float*)(ws + WS_MOD);
        for (int it = blockIdx.x; it < 4 * 144; it += G) {
            const int li = it / 144, j0 = (it % 144) * 64;
            const float* wp = a.in[I_WMOD] + (size_t)li * DM * NMOD + (size_t)(wave * 128) * NMOD + j0 + lane;
            float s0 = 0.f, s1 = 0.f, s2 = 0.f;
#pragma unroll 32
            for (int k = 0; k < 128; ++k) { const float w = wp[(size_t)k * NMOD]; const int kk = wave * 128 + k; s0 += sl[kk] * w; s1 += sl[DM + kk] * w; s2 += sl[2 * DM + kk] * w; }
            red[(wave * 3 + 0) * 64 + lane] = s0; red[(wave * 3 + 1) * 64 + lane] = s1; red[(wave * 3 + 2) * 64 + lane] = s2;
            __syncthreads();
            if (tid < 192) { const int m = tid >> 6; float s = a.in[I_BMOD][li * NMOD + j0 + lane];
#pragma unroll
                for (int w = 0; w < 8; ++w) s += red[(w * 3 + m) * 64 + lane];
                MOD[((size_t)li * 3 + m) * NMOD + j0 + lane] = s; }
            __syncthreads();
        }
    }
    for (int it = blockIdx.x; it < 2 * 4 * 16; it += G) {
        const int e = it >> 6, g = (it >> 4) & 3, nb = it & 15;
        const int n = nb * 64 + lane, k0 = wave * 16;
        const float* wo = a.in[I_WOUTA] + (size_t)e * DM * DM + (size_t)(512 + 128 * g) * DM + n;
        const float* ps = a.in[I_POOLS] + e * 512 + 128 * g;
        const float* pw = a.in[I_POOLW] + ((size_t)(e * 4 + g) * 128 + k0) * 128;
        float acc[16];
#pragma unroll
        for (int kk = 0; kk < 16; ++kk) acc[kk] = 0.f;
        for (int c = 0; c < 128; ++c) { const float wv = wo[(size_t)c * DM] * ps[c];
#pragma unroll
            for (int kk = 0; kk < 16; ++kk) acc[kk] += pw[kk * 128 + c] * wv; }
        bf16_t* dst = (bf16_t*)(ws + WS_WOUTA + e * SZ_WSQ) + (size_t)n * DM + 512 + 128 * g + k0;
        u32x4 w0, w1;
        w0.x = cvt_pk_bf16(acc[0], acc[1]); w0.y = cvt_pk_bf16(acc[2], acc[3]); w0.z = cvt_pk_bf16(acc[4], acc[5]); w0.w = cvt_pk_bf16(acc[6], acc[7]);
        w1.x = cvt_pk_bf16(acc[8], acc[9]); w1.y = cvt_pk_bf16(acc[10], acc[11]); w1.z = cvt_pk_bf16(acc[12], acc[13]); w1.w = cvt_pk_bf16(acc[14], acc[15]);
        *(u32x4*)dst = w0; *(u32x4*)(dst + 8) = w1;
    }
    {
        const int gt = blockIdx.x * 512 + tid, NGT = G * 512;
        bf16_t* wsp = (bf16_t*)(ws + WS_WSP);
        for (int i = gt; i < 2 * 8 * 128 * 128 / 2; i += NGT) { const f32x2 v = *(const f32x2*)(a.in[I_WSP] + 2 * (size_t)i); *(unsigned*)(wsp + 2 * (size_t)i) = cvt_pk_bf16(v.x, v.y); }
        float* rope = (float*)(ws + WS_ROPE);
        for (int i = gt; i < 128 * 16; i += NGT) {
            const int pos = i >> 4, f = i & 15;
            const float ang = (float)pos * INVF[f];
            double x = (double)ang; const double k = rint(x * 0.15915494309189535); x = fma(-k, 6.283185307179586, x);
            const double x2 = x * x; double ts = x, tc = 1.0, ss = x, cc = 1.0;
#pragma unroll
            for (int n = 1; n <= 14; ++n) { tc *= -x2 / (double)((2 * n - 1) * (2 * n)); ts *= -x2 / (double)((2 * n) * (2 * n + 1)); cc += tc; ss += ts; }
            rope[2 * i] = (float)cc; rope[2 * i + 1] = (float)ss;
        }
    }
}

__device__ __forceinline__ void bias_rows(const Args& a, int ls, int first, int nblk) {
    if ((int)blockIdx.x < first) return;
    unsigned char* ws = a.ws;
    int tid_ = threadIdx.x; asm volatile("" : "+v"(tid_));
    const int tid = tid_, lane = tid & 63, wave = __builtin_amdgcn_readfirstlane(tid >> 6);
    const int gw = ((int)blockIdx.x - first) * 8 + wave, NGW = nblk * 8;
    const float* MOD = (const float*)(ws + WS_MOD);
    {
        const int li = ls / 3, s = ls % 3;
        const bf16_t* Wt; int Nr;
        if (s == 1) { if (li & 1) { Wt = (const bf16_t*)(ws + WS_WINC + (li >> 1) * SZ_WINC); Nr = 2048; } else { Wt = (const bf16_t*)(ws + WS_WINA + (li >> 1) * SZ_WINA); Nr = 1280; } }
        else { Wt = (const bf16_t*)(ws + WS_W13 + (size_t)(li * 2 + (s >> 1)) * SZ_W13); Nr = NFF; }
        float sh[3][16];
#pragma unroll
        for (int mi = 0; mi < 3; ++mi)
#pragma unroll
            for (int j = 0; j < 2; ++j) { const float* sp = MOD + ((size_t)li * 3 + mi) * NMOD + (3 * s) * DM + 512 * j + 8 * lane;
                const f32x4 v0 = *(const f32x4*)sp, v1 = *(const f32x4*)(sp + 4);
                sh[mi][8 * j + 0] = v0.x; sh[mi][8 * j + 1] = v0.y; sh[mi][8 * j + 2] = v0.z; sh[mi][8 * j + 3] = v0.w; sh[mi][8 * j + 4] = v1.x; sh[mi][8 * j + 5] = v1.y; sh[mi][8 * j + 6] = v1.z; sh[mi][8 * j + 7] = v1.w; }
        float* BI = (float*)(ws + WS_BIAS) + (size_t)ls * 3 * NFF;
        for (int n4 = gw * 4; n4 < Nr; n4 += NGW * 4) {
            u32x4 w0[4], w1[4];
#pragma unroll
            for (int r = 0; r < 4; ++r) { w0[r] = *(const u32x4*)(Wt + (size_t)(n4 + r) * DM + 8 * lane); w1[r] = *(const u32x4*)(Wt + (size_t)(n4 + r) * DM + 512 + 8 * lane); }
            float dsum[4][3];
#pragma unroll
            for (int r = 0; r < 4; ++r) {
                float wv[16];
                wv[0] = bflo(w0[r].x); wv[1] = bfhi(w0[r].x); wv[2] = bflo(w0[r].y); wv[3] = bfhi(w0[r].y); wv[4] = bflo(w0[r].z); wv[5] = bfhi(w0[r].z); wv[6] = bflo(w0[r].w); wv[7] = bfhi(w0[r].w);
                wv[8] = bflo(w1[r].x); wv[9] = bfhi(w1[r].x); wv[10] = bflo(w1[r].y); wv[11] = bfhi(w1[r].y); wv[12] = bflo(w1[r].z); wv[13] = bfhi(w1[r].z); wv[14] = bflo(w1[r].w); wv[15] = bfhi(w1[r].w);
                float d0 = 0.f, d1 = 0.f, d2 = 0.f;
#pragma unroll
                for (int k = 0; k < 16; ++k) { d0 += sh[0][k] * wv[k]; d1 += sh[1][k] * wv[k]; d2 += sh[2][k] * wv[k]; }
                dsum[r][0] = wave_sum(d0); dsum[r][1] = wave_sum(d1); dsum[r][2] = wave_sum(d2);
            }
            if (lane < 12) { const int r = lane & 3, m = lane >> 2; float v = dsum[0][0];
#pragma unroll
                for (int rr = 0; rr < 4; ++rr)
#pragma unroll
                    for (int mm = 0; mm < 3; ++mm) if (r == rr && m == mm) v = dsum[rr][mm];
                BI[(size_t)m * NFF + n4 + r] = v; }
        }
    }
}

__device__ __forceinline__ void phase_p0b(const Args& a) {
    unsigned char* ws = a.ws;
    int tid_ = threadIdx.x; asm volatile("" : "+v"(tid_));
    const int tid = tid_, lane = tid & 63, wave = __builtin_amdgcn_readfirstlane(tid >> 6), G = gridDim.x;
    const int gw = blockIdx.x * 8 + wave, NGW = G * 8;
    const float* MOD = (const float*)(ws + WS_MOD);
    {
        float* GS = (float*)(ws + WS_GS);
        for (int i = blockIdx.x * 512 + tid; i < 12 * 3 * DM; i += G * 512) { const int col = i & 1023, mi = (i >> 10) % 3, ls = i / (3 * DM), li = ls / 3, s = ls % 3;
            GS[i] = a.in[I_NORMG][(size_t)ls * DM + col] * (1.0f + MOD[((size_t)li * 3 + mi) * NMOD + (3 * s + 1) * DM + col]); }
    }
    for (int ls = 0; ls < 12; ++ls) if (ls < 3 || ls % 3 == 1) bias_rows(a, ls, 0, G);
    {
        bf16_t* AH = (bf16_t*)(ws + WS_AH); float* SS = (float*)(ws + WS_SS);
        for (int row = gw; row < MT; row += NGW) {
            const int mi = row < SEQ ? 0 : (row < ML ? 1 : 2);
            const float* xr = (row < ML) ? a.in[I_X] + (size_t)row * DM : a.in[I_CTX] + (size_t)(row - ML) * DM;
            const float* gp = a.in[I_NORMG];
            const float* scp = MOD + (size_t)mi * NMOD + DM;
            float ssq = 0.f;
#pragma unroll
            for (int j = 0; j < 4; ++j) { const int col = 256 * j + 4 * lane;
                const f32x4 v = *(const f32x4*)(xr + col), g = *(const f32x4*)(gp + col), sc = *(const f32x4*)(scp + col);
                ssq += (v.x * v.x + v.y * v.y) + (v.z * v.z + v.w * v.w);
                const f32x4 o = v * g * (sc + 1.0f);
                u32x2 w; w.x = cvt_pk_bf16(o.x, o.y); w.y = cvt_pk_bf16(o.z, o.w);
                *(u32x2*)(AH + (size_t)row * DM + col) = w; }
            ssq = wave_sum(ssq);
            if (lane < 16) SS[(size_t)row * 16 + lane] = (lane == 0) ? ssq : 0.f;
        }
    }
}

template <int HW> __device__ __forceinline__ void pool_rows(const unsigned* __restrict__ Pc, bf16_t* __restrict__ AOc, int t0, int n) {
    unsigned w[32 + 2 * HW];
#pragma unroll
    for (int j = 0; j < 32 + 2 * HW; ++j) { const int t = t0 - HW + j; w[j] = (t >= 0 && t < n) ? Pc[(size_t)t * 256] : 0u; }
    float s0 = 0.f, s1 = 0.f;
#pragma unroll
    for (int j = 0; j < 2 * HW; ++j) { s0 += bflo(w[j]); s1 += bfhi(w[j]); }
#pragma unroll
    for (int i = 0; i < 32; ++i) {
        const int t = t0 + i, lo = max(t - HW, 0), hi_ = min(t + HW, n);
        const float inv = 1.0f / (float)(hi_ - lo);
        *(unsigned*)(AOc + (size_t)t * DM) = cvt_pk_bf16(s0 * inv - bflo(w[i + HW]), s1 * inv - bfhi(w[i + HW]));
        if (i < 31) { s0 += bflo(w[i + 2 * HW]) - bflo(w[i]); s1 += bfhi(w[i + 2 * HW]) - bfhi(w[i]); }
    }
}
__device__ __forceinline__ void pool_unit(const bf16_t* P, bf16_t* AO, int unit) {
    int tid_ = threadIdx.x; asm volatile("" : "+v"(tid_));
    const int tid = tid_, half = tid >> 8, cp = tid & 255, g = __builtin_amdgcn_readfirstlane(cp >> 6);
    const int row0 = unit * 64 + half * 32;
    int base, n;
    if (row0 < ML) { base = row0 & ~(SEQ - 1); n = SEQ; } else { base = ML + ((row0 - ML) & ~(CTXL - 1)); n = CTXL; }
    const int t0 = row0 - base;
    const unsigned* Pc = (const unsigned*)(P + (size_t)base * 512) + cp;
    bf16_t* AOc = AO + (size_t)base * DM + 512 + 2 * cp;
    if (g == 0) pool_rows<1>(Pc, AOc, t0, n); else if (g == 1) pool_rows<2>(Pc, AOc, t0, n); else if (g == 2) pool_rows<4>(Pc, AOc, t0, n); else pool_rows<8>(Pc, AOc, t0, n);
}

__device__ __forceinline__ void spatial_unit(const Args& a, LAS unsigned char* lds, int o, int ch, int g) {
    unsigned char* ws = a.ws;
    int tid_ = threadIdx.x; asm volatile("" : "+v"(tid_));
    const int tid = tid_, lane = tid & 63, wave = __builtin_amdgcn_readfirstlane(tid >> 6);
    const bf16_t* U = (const bf16_t*)(ws + WS_H); const bf16_t* V = U + (size_t)MT * DM; const float* VSS = (const float*)(ws + WS_VSS);
    bf16_t* Gout = (bf16_t*)(ws + WS_AO);
    LAS bf16_t* VnT = (LAS bf16_t*)lds;
    LAS float* rst = (LAS float*)(lds + 128 * 136 * 2);
    const int r0 = ch * 128;
    if (tid < 128) { const float* p = VSS + (size_t)(r0 + tid) * 16; const f32x4 v0 = *(const f32x4*)p, v1 = *(const f32x4*)(p + 4), v2 = *(const f32x4*)(p + 8), v3 = *(const f32x4*)(p + 12);
        const float s = ((v0.x + v0.y) + (v0.z + v0.w)) + ((v1.x + v1.y) + (v1.z + v1.w)) + ((v2.x + v2.y) + (v2.z + v2.w)) + ((v3.x + v3.y) + (v3.z + v3.w));
        rst[tid] = 1.0f / sqrtf(s * (1.0f / 1024.0f) + EPS); }
    __syncthreads();
    const float* vg = a.in[I_VNG] + (size_t)o * DM + g * 128;
#pragma unroll
    for (int it = 0; it < 4; ++it) {
        const int idx = tid + 512 * it, q = idx >> 4, c8 = (idx & 15) * 8;
        const u32x4 w = *(const u32x4*)(V + (size_t)(r0 + q) * DM + g * 128 + c8);
        const f32x4 g0 = *(const f32x4*)(vg + c8), g1 = *(const f32x4*)(vg + c8 + 4);
        const float rs = rst[q];
        const float v[8] = {bflo(w.x) * rs * g0.x, bfhi(w.x) * rs * g0.y, bflo(w.y) * rs * g0.z, bfhi(w.y) * rs * g0.w, bflo(w.z) * rs * g1.x, bfhi(w.z) * rs * g1.y, bflo(w.w) * rs * g1.z, bfhi(w.w) * rs * g1.w};
#pragma unroll
        for (int e = 0; e < 8; e += 2) { const unsigned pk = cvt_pk_bf16(v[e], v[e + 1]); VnT[(c8 + e) * 136 + q] = (bf16_t)(pk & 0xffffu); VnT[(c8 + e + 1) * 136 + q] = (bf16_t)(pk >> 16); }
    }
    __syncthreads();
    const int pl = lane & 15, kq = lane >> 4, p = wave * 16 + pl;
    const bf16_t* wsp = (const bf16_t*)(ws + WS_WSP) + ((size_t)(o * 8 + g) * 128 + p) * 128;
    bf16x8 bw[4];
#pragma unroll
    for (int ks = 0; ks < 4; ++ks) bw[ks] = *(const bf16x8*)(wsp + 32 * ks + 8 * kq);
    f32x4 acc[8];
#pragma unroll
    for (int nb = 0; nb < 8; ++nb) { acc[nb] = (f32x4){0.f, 0.f, 0.f, 0.f};
#pragma unroll
        for (int ks = 0; ks < 4; ++ks) { const bf16x8 av = *(const LAS bf16x8*)(VnT + (16 * nb + pl) * 136 + 32 * ks + 8 * kq);
            acc[nb] = __builtin_amdgcn_mfma_f32_16x16x32_bf16(av, bw[ks], acc[nb], 0, 0, 0); } }
    const float bsp = a.in[I_BSP][(size_t)(o * 8 + g) * 128 + p];
    const size_t ro = (size_t)(r0 + p) * DM + g * 128 + 4 * kq;
#pragma unroll
    for (int nb = 0; nb < 8; ++nb) { const u32x2 uw = *(const u32x2*)(U + ro + 16 * nb);
        u32x2 w; w.x = cvt_pk_bf16(bflo(uw.x) * (acc[nb].x + bsp), bfhi(uw.x) * (acc[nb].y + bsp)); w.y = cvt_pk_bf16(bflo(uw.y) * (acc[nb].z + bsp), bfhi(uw.y) * (acc[nb].w + bsp));
        *(u32x2*)(Gout + ro + 16 * nb) = w; }
    __syncthreads();
}

__global__ void __launch_bounds__(512, 2) fwd_megakernel(Args a) {
    extern __shared__ __attribute__((aligned(16))) unsigned char lds_raw[];
    LAS unsigned char* lds = (LAS unsigned char*)lds_raw;
    unsigned char* ws = a.ws;
    const int G = gridDim.x, lo = a.ph_lo, hi = a.ph_hi;
    int ph = 0;
    volatile LAS unsigned* misc = (volatile LAS unsigned*)(lds + LDS_MISC);
    XcdBarrier bar; bar.bar = (unsigned*)(ws + WS_CTL); bar.x = 0; bar.st = misc;
    if (hi - lo > 1) {
        if (threadIdx.x == 0) { misc[0] = 0u; misc[1] = 0u; }
        __syncthreads();
        bar = xcd_barrier_post((unsigned*)(ws + WS_CTL), misc);
    }
#define PHASE_BEGIN if (ph >= lo && ph < hi) {
#define PHASE_END   if (ph + 1 < hi) { if (lo < 0) cg::this_grid().sync(); else xcd_barrier(bar); } } ++ph;

    PHASE_BEGIN phase_p0(a, lds); PHASE_END
    PHASE_BEGIN phase_p0b(a); PHASE_END

    const float* MOD = (const float*)(ws + WS_MOD);
    bf16_t* X = (bf16_t*)(ws + WS_X); bf16_t* AH = (bf16_t*)(ws + WS_AH); float* SS = (float*)(ws + WS_SS); bf16_t* H = (bf16_t*)(ws + WS_H);
    bf16_t* AO = (bf16_t*)(ws + WS_AO);
    for (int L = 0; L < 4; ++L) {
        const bool even = (L & 1) == 0;
        const int Mfull = (L <= 2) ? MT : ML;
        const int Mlate = (L <= 1) ? MT : ML;
        const float* BIAS = (const float*)(ws + WS_BIAS) + (size_t)(L * 3) * 3 * NFF;
        const float* GS = (const float*)(ws + WS_GS) + (size_t)(L * 3) * 3 * DM;
        const float* MODL = MOD + (size_t)L * 3 * NMOD;
        PHASE_BEGIN {
            pg8::Gemm g{AH, (const bf16_t*)(ws + WS_W13 + (size_t)(L * 2) * SZ_W13), Mfull, NFF, DM}; pg8::StaticOrder S; S.init(Mfull, NFF, G, (int)blockIdx.x);
            pg8::EpiSwiGLU E{H, SS, BIAS};
            pg8::gemm_phase<pg8::EpiSwiGLU, pg8::StaticOrder, true, true>(lds, g, S, E);
            { const int rem = S.nwg % G, first = rem ? rem : 0, nidle = G - first;
              if (L >= 1) bias_rows(a, L * 3 + 2, first, nidle);
              if (L < 3) convert_w2(a, lds, (L + 1) * 2, first, nidle); }
        } PHASE_END
        PHASE_BEGIN {
            const bf16_t* Wt = (const bf16_t*)(ws + WS_W2 + (size_t)(L * 2) * SZ_W2);
            pg8::Gemm g{H, Wt, ML, DM, DFF}; pg8::StaticOrder S; S.init(ML, DM, G, (int)blockIdx.x);
            pg8::EpiResid E{a.in[I_X], a.in[I_CTX], L == 0 ? nullptr : X, X, nullptr, MODL + 2 * DM, GS + 3 * DM, AH, SS, 0.5f, 0};
            if (Mfull == MT) for (int t = blockIdx.x; t < 256; t += G) ctx_gemm_resid<11>(lds, H, Wt, E, t);
            pg8::gemm_phase<pg8::EpiResid, pg8::StaticOrder, true, true>(lds, g, S, E);
        } PHASE_END
        PHASE_BEGIN {
            if (even) {
                pg8::Gemm g{AH, (const bf16_t*)(ws + WS_WINA + (size_t)(L >> 1) * SZ_WINA), Mfull, 1280, DM}; pg8::StaticOrder S; S.init(Mfull, 1280, G, (int)blockIdx.x);
                pg8::EpiInA E{SS, BIAS + 3 * NFF, a.in[I_QKG] + (L >> 1) * 128, (const float*)(ws + WS_ROPE), (bf16_t*)(ws + WS_Q), (bf16_t*)(ws + WS_KB), (bf16_t*)(ws + WS_VB), (bf16_t*)(ws + WS_P)};
                pg8::gemm_phase<pg8::EpiInA, pg8::StaticOrder, true, true>(lds, g, S, E);
                { const int rem = S.nwg % G, first = rem ? rem : 0; if (L < 3) { convert_w13(a, lds, (L + 1) * 2, first, G - first); convert_w2(a, lds, (L + 1) * 2 + 1, first, G - first); } }
            } else {
                pg8::Gemm g{AH, (const bf16_t*)(ws + WS_WINC + (size_t)(L >> 1) * SZ_WINC), Mlate, 2048, DM}; pg8::StaticOrder S; S.init(Mlate, 2048, G, (int)blockIdx.x);
                pg8::EpiInC E{SS, BIAS + 3 * NFF, H, H + (size_t)MT * DM, (float*)(ws + WS_VSS)};
                pg8::gemm_phase<pg8::EpiInC, pg8::StaticOrder, true, true>(lds, g, S, E);
                { const int rem = S.nwg % G, first = rem ? rem : 0; if (L < 3) { convert_w13(a, lds, (L + 1) * 2, first, G - first); convert_w2(a, lds, (L + 1) * 2 + 1, first, G - first); } }
            }
        } PHASE_END
        PHASE_BEGIN {
            if (even) {
                const attn_body::bf16* Qb = (const attn_body::bf16*)(ws + WS_Q); const attn_body::bf16* Kb = (const attn_body::bf16*)(ws + WS_KB); const attn_body::bf16* Vb = (const attn_body::bf16*)(ws + WS_VB);
                attn_body::bf16* Ob = (attn_body::bf16*)AO;
                const int bid = blockIdx.x;
                for (int r = 0; ; ++r) {
                    int uidx;
                    if (G == 256) { if (r >= 2) break; const int x = bid & 7; uidx = (x >> 1) * 128 + (x & 1) * 64 + (bid >> 3) * 2 + r; }
                    else { uidx = bid + r * G; if (uidx >= 512) break; }
                    const int combo = uidx >> 7, idx = uidx & 127, b = combo >> 1, kvh = combo & 1, h = kvh * 4 + (idx >> 5), qb = idx & 31;
                    const size_t qrow = (size_t)b * SEQ + qb * 256;
                    attn_body::attn_unit<8>(Qb + qrow * 512 + h * 64, Kb + (size_t)(b * 2 + kvh) * KVROWS * 64, Vb + (size_t)(b * 2 + kvh) * KVROWS * 64, KVROWS / 64, Ob + qrow * DM + h * 64, (char*)lds_raw);
                }
                const int nctx = (L == 0) ? 16 : 0, npool = (L == 0) ? MT / 64 : ML / 64;
                for (int it = blockIdx.x; it < nctx + npool; it += G) {
                    if (it < nctx) { const int b = it >> 3, h = it & 7, kvh = h >> 2; const size_t qrow = (size_t)ML + b * CTXL;
                        attn_body::attn_unit<8>(Qb + qrow * 512 + h * 64, Kb + (size_t)(b * 2 + kvh) * KVROWS * 64, Vb + (size_t)(b * 2 + kvh) * KVROWS * 64, CTXL / 64, Ob + qrow * DM + h * 64, (char*)lds_raw); }
                    else pool_unit((const bf16_t*)(ws + WS_P), AO, it - nctx);
                }
            } else {
                const int nch = Mlate / 128;
                for (int it = blockIdx.x; it < nch * 8; it += G) spatial_unit(a, lds, L >> 1, it >> 3, it & 7);
            }
        } PHASE_END
        PHASE_BEGIN {
            const bf16_t* Wt = even ? (const bf16_t*)(ws + WS_WOUTA + (size_t)(L >> 1) * SZ_WSQ) : (const bf16_t*)(ws + WS_WOUTC + (size_t)(L >> 1) * SZ_WSQ);
            pg8::Gemm g{AO, Wt, ML, DM, DM}; pg8::StaticOrder S; S.init(ML, DM, G, (int)blockIdx.x);
            pg8::EpiResid E{a.in[I_X], a.in[I_CTX], X, X, nullptr, MODL + 5 * DM, GS + 2 * 3 * DM, AH, SS, 1.0f, 0};
            if (Mlate == MT) for (int t = blockIdx.x; t < 256; t += G) ctx_gemm_resid<4>(lds, AO, Wt, E, t);
            pg8::gemm_phase<pg8::EpiResid, pg8::StaticOrder, true, true>(lds, g, S, E);
        } PHASE_END
        PHASE_BEGIN {
            pg8::Gemm g{AH, (const bf16_t*)(ws + WS_W13 + (size_t)(L * 2 + 1) * SZ_W13), Mlate, NFF, DM}; pg8::StaticOrder S; S.init(Mlate, NFF, G, (int)blockIdx.x);
            pg8::EpiSwiGLU E{H, SS, BIAS + 2 * 3 * NFF};
            pg8::gemm_phase<pg8::EpiSwiGLU, pg8::StaticOrder, true, true>(lds, g, S, E);
            { const int rem = S.nwg % G, first = rem ? rem : 0, nidle = G - first;
              if (L < 3) { convert_w13(a, lds, (L + 1) * 2 + 1, first, nidle); bias_rows(a, (L + 1) * 3, first, nidle); } }
        } PHASE_END
        PHASE_BEGIN {
            const bf16_t* Wt = (const bf16_t*)(ws + WS_W2 + (size_t)(L * 2 + 1) * SZ_W2);
            pg8::Gemm g{H, Wt, ML, DM, DFF}; pg8::StaticOrder S; S.init(ML, DM, G, (int)blockIdx.x);
            pg8::EpiResid E{a.in[I_X], a.in[I_CTX], X, X, L == 3 ? a.out : nullptr, MODL + 8 * DM, L == 3 ? nullptr : GS + (size_t)3 * 3 * DM, AH, SS, 0.5f, 0};
            if (Mlate == MT) for (int t = blockIdx.x; t < 256; t += G) ctx_gemm_resid<11>(lds, H, Wt, E, t);
            pg8::gemm_phase<pg8::EpiResid, pg8::StaticOrder, true, true>(lds, g, S, E);
        } PHASE_END
    }
#undef PHASE_BEGIN
#undef PHASE_END
}

constexpr int N_PHASES = 2 + 4 * 7;

extern "C" void kernel_launch(void* const* d_in, const int* in_sizes, int n_in, void* d_out, int out_size, void* d_ws, size_t ws_size, hipStream_t stream) {
    static int grid = 0;
    if (grid == 0) {
        if (n_in != 19 || ws_size < WS_END) { fprintf(stderr, "kernel_launch: unexpected inputs (n_in %d, ws %zu, need %zu)\n", n_in, ws_size, (size_t)WS_END); grid = -1; return; }
        int dev = 0, cus = 0, per_cu = 0;
        hipGetDevice(&dev);
        hipDeviceGetAttribute(&cus, hipDeviceAttributeMultiprocessorCount, dev);
        if (hipFuncSetAttribute((const void*)fwd_megakernel, hipFuncAttributeMaxDynamicSharedMemorySize, LDS_BYTES) != hipSuccess) { fprintf(stderr, "kernel_launch: hipFuncSetAttribute failed\n"); grid = -1; return; }
        if (hipOccupancyMaxActiveBlocksPerMultiprocessor(&per_cu, (const void*)fwd_megakernel, 512, LDS_BYTES) != hipSuccess || per_cu < 1) { fprintf(stderr, "kernel_launch: occupancy query says %d\n", per_cu); per_cu = 1; }
        (void)hipGetLastError();
        grid = cus * (per_cu > 1 ? 1 : per_cu);
        if (grid <= 0) grid = 256;
    }
    if (grid < 0) return;
    Args a{};
    for (int i = 0; i < 19; ++i) a.in[i] = (const float*)d_in[i];
    a.out = (float*)d_out; a.ws = (unsigned char*)d_ws;
#if MK_PER_PHASE
    for (int p = 0; p < N_PHASES; ++p) { a.ph_lo = p; a.ph_hi = p + 1; hipLaunchKernelGGL(fwd_megakernel, dim3(grid), dim3(512), LDS_BYTES, stream, a); }
#else
    a.ph_lo = 0; a.ph_hi = N_PHASES;
    if (hipMemsetAsync((char*)d_ws + WS_CTL, 0, CTL_BYTES, stream) != hipSuccess) { fprintf(stderr, "kernel_launch: memset of the barrier words failed\n"); return; }
    void* args[] = {&a};
    hipError_t e = hipLaunchCooperativeKernel((const void*)fwd_megakernel, dim3(grid), dim3(512), args, LDS_BYTES, stream);
    if (e != hipSuccess) fprintf(stderr, "cooperative launch failed: %s (grid %d)\n", hipGetErrorString(e), grid);
#endif
}
```

```cpp
#include <hip/hip_runtime.h>
#include <hip/hip_cooperative_groups.h>
#include <hip/hip_bf16.h>
#include <cstdio>
#include <cstdint>
namespace cg = cooperative_groups;

#ifndef RESID_NBUF
#define RESID_NBUF 3
#endif
#ifndef MK_PER_PHASE
#define MK_PER_PHASE 0
#endif

#define LAS __attribute__((address_space(3)))
typedef unsigned short bf16_t;
typedef short bf16x8 __attribute__((ext_vector_type(8)));
typedef float f32x4 __attribute__((ext_vector_type(4)));
typedef float f32x2 __attribute__((ext_vector_type(2)));
typedef unsigned u32x4 __attribute__((ext_vector_type(4)));
typedef unsigned u32x2 __attribute__((ext_vector_type(2)));

constexpr int DM = 1024, SEQ = 8192, CTXL = 256, ML = 16384, MC = 512, MT = ML + MC, DFF = 2816, NFF = 5632;
constexpr int KVROWS = CTXL + SEQ;
constexpr int NMOD = 9 * DM;
constexpr float EPS = 1e-6f;
constexpr float QSCALE = 0.125f * 1.4426950408889634f;

constexpr size_t SZ_W13 = (size_t)NFF * DM * 2, SZ_W2 = (size_t)DM * DFF * 2, SZ_WINA = (size_t)1280 * DM * 2, SZ_WSQ = (size_t)DM * DM * 2, SZ_WINC = (size_t)2048 * DM * 2, SZ_WSP = (size_t)8 * 128 * 128 * 2;
constexpr size_t WS_W13 = 0;
constexpr size_t WS_W2 = WS_W13 + 8 * SZ_W13;
constexpr size_t WS_WINA = WS_W2 + 8 * SZ_W2;
constexpr size_t WS_WOUTA = WS_WINA + 2 * SZ_WINA;
constexpr size_t WS_WINC = WS_WOUTA + 2 * SZ_WSQ;
constexpr size_t WS_WOUTC = WS_WINC + 2 * SZ_WINC;
constexpr size_t WS_WSP = WS_WOUTC + 2 * SZ_WSQ;
constexpr size_t WS_MOD = WS_WSP + 2 * SZ_WSP;
constexpr size_t WS_BIAS = WS_MOD + (size_t)4 * 3 * NMOD * 4;
constexpr size_t WS_GS = WS_BIAS + (size_t)12 * 3 * NFF * 4;
constexpr size_t WS_ROPE = WS_GS + (size_t)12 * 3 * DM * 4;
constexpr size_t WS_SS = WS_ROPE + (size_t)128 * 16 * 2 * 4;
constexpr size_t WS_VSS = WS_SS + (size_t)MT * 16 * 4;
constexpr size_t WS_X = WS_VSS + (size_t)MT * 16 * 4;
constexpr size_t WS_AH = WS_X + (size_t)MT * DM * 4;
constexpr size_t WS_H = WS_AH + (size_t)MT * DM * 2;
constexpr size_t WS_Q = WS_H + (size_t)MT * DFF * 2;
constexpr size_t WS_KB = WS_Q + (size_t)MT * 512 * 2;
constexpr size_t WS_VB = WS_KB + (size_t)2 * KVROWS * 128 * 2;
constexpr size_t WS_P = WS_VB + (size_t)2 * KVROWS * 128 * 2;
constexpr size_t WS_AO = WS_P + (size_t)MT * 512 * 2;
constexpr size_t WS_CTL = WS_AO + (size_t)MT * DM * 2;
constexpr size_t CTL_BYTES = 16384;
constexpr size_t WS_END = WS_CTL + CTL_BYTES;
static_assert(WS_W2 % 256 == 0 && WS_MOD % 256 == 0 && WS_BIAS % 256 == 0 && WS_SS % 256 == 0 && WS_X % 256 == 0 && WS_H % 256 == 0 && WS_KB % 256 == 0 && WS_AO % 256 == 0, "ws alignment");

constexpr int LDS_BYTES = 147456;
constexpr int LDS_SILU = 131072;
constexpr int LDS_MISC = LDS_BYTES - 256;

__device__ __forceinline__ unsigned cvt_pk_bf16(float lo, float hi) { unsigned r; asm volatile("v_cvt_pk_bf16_f32 %0, %1, %2" : "=v"(r) : "v"(lo), "v"(hi)); return r; }
__device__ __forceinline__ float bf2f(unsigned short h) { return __uint_as_float((unsigned)h << 16); }
__device__ __forceinline__ float bflo(unsigned w) { return __uint_as_float(w << 16); }
__device__ __forceinline__ float bfhi(unsigned w) { return __uint_as_float(w & 0xffff0000u); }
typedef _Float16 h16x2 __attribute__((ext_vector_type(2)));
__device__ __forceinline__ unsigned pk_h2(float lo, float hi) { f32x2 v; v.x = __builtin_fminf(__builtin_fmaxf(lo, -65000.f), 65000.f); v.y = __builtin_fminf(__builtin_fmaxf(hi, -65000.f), 65000.f);
    const h16x2 h = __builtin_convertvector(v, h16x2); return __builtin_bit_cast(unsigned, h); }
__device__ __forceinline__ f32x2 unpk_h2(unsigned w) { const h16x2 h = __builtin_bit_cast(h16x2, w); return __builtin_convertvector(h, f32x2); }
__device__ __forceinline__ float fast_rcp(float x) { return __builtin_amdgcn_rcpf(x); }
__device__ __forceinline__ float silu_f(float a) { return a * fast_rcp(1.0f + __builtin_amdgcn_exp2f(-1.4426950408889634f * a)); }
__device__ __forceinline__ float gelu_tanh_f(float x) { const float t = x * (-2.3022081986f + -0.1029432396f * x * x); return x * fast_rcp(1.0f + __builtin_amdgcn_exp2f(t)); }
__device__ __forceinline__ float wave_sum(float v) {
#pragma unroll
    for (int o = 1; o < 64; o <<= 1) v += __shfl_xor(v, o);
    return v;
}
__device__ __forceinline__ int mod_index_of_tile(int pm) { return pm < 32 ? 0 : (pm < 64 ? 1 : 2); }
__device__ __forceinline__ float row_rstd16(const float* SS, int row, int fq) {
    const f32x4 v = *(const f32x4*)(SS + (size_t)row * 16 + 4 * fq);
    float s = (v.x + v.y) + (v.z + v.w);
    s += __shfl_xor(s, 16); s += __shfl_xor(s, 32);
    return 1.0f / sqrtf(s * (1.0f / 1024.0f) + EPS);
}

__device__ __forceinline__ void row_rstd16x8(const float* SS, int row0, int fq, float (&rs)[2][4]) {
    f32x4 v[2][4];
#pragma unroll
    for (int ai = 0; ai < 2; ++ai)
#pragma unroll
        for (int m = 0; m < 4; ++m) v[ai][m] = *(const f32x4*)(SS + (size_t)(row0 + ai * 128 + m * 16) * 16 + 4 * fq);
#pragma unroll
    for (int ai = 0; ai < 2; ++ai)
#pragma unroll
        for (int m = 0; m < 4; ++m) { float t = (v[ai][m].x + v[ai][m].y) + (v[ai][m].z + v[ai][m].w); t += __shfl_xor(t, 16); t += __shfl_xor(t, 32); rs[ai][m] = 1.0f / sqrtf(t * (1.0f / 1024.0f) + EPS); }
}

namespace pg8 {
constexpr int BM = 256, BK = 64, HALF = 128, HTB = HALF * BK * 2, STAGE_BYTES = 8 * HTB, NXCD = 8, WGM = 8;
__host__ __device__ __forceinline__ int lds_byte(int r, int c) { const int st = (r >> 4) * 2 + (c >> 5), rr = r & 15, cc = c & 31, ob = rr * 64 + cc * 2; return st * 1024 + (ob ^ (((ob >> 9) & 1) << 5)); }
__host__ __device__ __forceinline__ void stage_rc(int b, int& R, int& C) { const int st = b / 1024, sb = b % 1024, swz = sb ^ (((sb >> 9) & 1) << 5); R = (st >> 1) * 16 + swz / 64; C = (st & 1) * 32 + (swz % 64) / 2; }
__host__ __device__ __forceinline__ int perm32(int rho) { const int n = rho >> 4, i = rho & 15; return 8 * (i >> 2) + 4 * n + (i & 3); }
struct Unit { int pm, pn; };
struct Gemm { const bf16_t* A; const bf16_t* Bt; int M, N, K; };
struct StaticOrder {
    int nM, nN, nwg, G, c;
    __host__ __device__ void init(int M, int N, int G_, int c_) { nM = M / BM; nN = N / BM; nwg = nM * nN; G = G_; c = c_; }
    __host__ __device__ bool next(int i, Unit& u) const {
        const long L = (long)i * G + c; if (L >= nwg) return false;
        int wgid = (int)L; { const int q = nwg / NXCD, r = nwg % NXCD, xcd = wgid % NXCD, off = wgid / NXCD; wgid = (xcd < r ? xcd * (q + 1) : r * (q + 1) + (xcd - r) * q) + off; }
        const int nig = WGM * nN, gid = wgid / nig, fm = gid * WGM, gsz = (nM - fm) < WGM ? (nM - fm) : WGM;
        u.pm = fm + ((wgid % nig) % gsz); u.pn = (wgid % nig) / gsz; return true;
    }
    __device__ __forceinline__ void a_ready(const Unit&) const {}
    __device__ __forceinline__ void done(const Unit&) const {}
};

template <class Epi, class Sched, bool ALIGN_EPI = false, bool SP2 = false>
__device__ __forceinline__ void gemm_phase(LAS unsigned char* lds, const Gemm g, const Sched& S, const Epi& E) {
    int tid_ = threadIdx.x; asm volatile("" : "+v"(tid_));
    const int tid = tid_, wid = __builtin_amdgcn_readfirstlane(tid >> 6), lane = tid & 63, wr = wid >> 2, wc = wid & 3, fr = lane & 15, fq = lane >> 4;
    const int K = g.K, nt = K / BK;
    unsigned voffA[2], voffB[2];
#pragma unroll
    for (int i = 0; i < 2; ++i) { int R, C; stage_rc(tid * 16 + i * 8192, R, C); const int Rb = Epi::PERM ? ((R & ~31) + perm32(R & 31)) : R;
        voffA[i] = (unsigned)(R * K + C) * 2u; voffB[i] = (unsigned)(Rb * K + C) * 2u; }
    const size_t kstep = (size_t)(BK * 2);
    const size_t hstep = (size_t)HALF * K * 2;
    const size_t tstep = 2 * hstep;
    const unsigned ldsw = (unsigned)wid * 1024u;
    const int aoff = lds_byte(wr * 64 + fr, fq * 8), boff = lds_byte(wc * 32 + fr, fq * 8);
#define PG8_SA(b, h) (((b) * 2 + (h)) * HTB)
#define PG8_SB(b, h) ((4 + (b) * 2 + (h)) * HTB)
#define PG8_STAGE(bufoff, gbase, voff) do { _Pragma("unroll") for (int _i = 0; _i < 2; ++_i) \
        __builtin_amdgcn_global_load_lds((const unsigned*)((const char*)(gbase) + (voff)[_i]), (LAS unsigned*)(lds + (bufoff) + ldsw + _i * 8192), 16, 0, 0); } while (0)
#define PG8_LDA(dst, b, h) do { _Pragma("unroll") for (int m = 0; m < 4; ++m) _Pragma("unroll") for (int k = 0; k < 2; ++k) dst[m][k] = *(const LAS bf16x8*)(lds + PG8_SA(b, h) + aoff + m * 2048 + k * 1024); } while (0)
#define PG8_LDB(dst, b, h) do { _Pragma("unroll") for (int n = 0; n < 2; ++n) _Pragma("unroll") for (int k = 0; k < 2; ++k) dst[n][k] = *(const LAS bf16x8*)(lds + PG8_SB(b, h) + boff + n * 2048 + k * 1024); } while (0)
#define PG8_MMA(ai, bj, At, Bt) do { __builtin_amdgcn_s_setprio(1); _Pragma("unroll") for (int m = 0; m < 4; ++m) _Pragma("unroll") for (int n = 0; n < 2; ++n) _Pragma("unroll") for (int k = 0; k < 2; ++k) \
        acc[ai][bj][m][n] = __builtin_amdgcn_mfma_f32_16x16x32_bf16(Bt[n][k], At[m][k], acc[ai][bj][m][n], 0, 0, 0); __builtin_amdgcn_s_setprio(0); } while (0)
#define PG8_WAIT_V(n) asm volatile("s_waitcnt vmcnt(" #n ")" ::: "memory")
#define PG8_WAIT_L(n) asm volatile("s_waitcnt lgkmcnt(" #n ")" ::: "memory")
#define PG8_BAR __builtin_amdgcn_s_barrier()
#define PG8_SCHED __builtin_amdgcn_sched_barrier(0)
    Unit cur, nxt; int ui = 0;
    if (!S.next(0, cur)) return;
    f32x4 acc[2][2][4][2];
#pragma unroll
    for (int a = 0; a < 2; ++a)
#pragma unroll
        for (int b = 0; b < 2; ++b)
#pragma unroll
            for (int m = 0; m < 4; ++m)
#pragma unroll
                for (int n = 0; n < 2; ++n) acc[a][b][m][n] = (f32x4){0.f, 0.f, 0.f, 0.f};
    bf16x8 At[4][2], B0[2][2], B1[2][2];
    const char* cA = (const char*)g.A + (size_t)cur.pm * tstep; const char* cB = (const char*)g.Bt + (size_t)cur.pn * tstep;
    S.a_ready(cur);
    if constexpr (SP2) {
        PG8_STAGE(PG8_SB(0, 0), cB, voffB); PG8_STAGE(PG8_SB(0, 1), cB + hstep, voffB); PG8_STAGE(PG8_SA(0, 0), cA, voffA); PG8_STAGE(PG8_SA(0, 1), cA + hstep, voffA);
        if (wr == 1) PG8_BAR;
        PG8_WAIT_V(2); PG8_BAR;
        PG8_STAGE(PG8_SB(1, 0), cB + kstep, voffB); PG8_STAGE(PG8_SA(1, 0), cA + kstep, voffA); PG8_STAGE(PG8_SB(1, 1), cB + hstep + kstep, voffB);
        PG8_WAIT_V(6); PG8_BAR;
    } else {
        PG8_STAGE(PG8_SB(0, 0), cB, voffB); PG8_STAGE(PG8_SA(0, 0), cA, voffA); PG8_STAGE(PG8_SB(0, 1), cB + hstep, voffB); PG8_STAGE(PG8_SA(0, 1), cA + hstep, voffA);
        if (wr == 1) PG8_BAR;
        PG8_WAIT_V(4); PG8_BAR;
        PG8_STAGE(PG8_SB(1, 0), cB + kstep, voffB); PG8_STAGE(PG8_SA(1, 0), cA + kstep, voffA); PG8_STAGE(PG8_SB(1, 1), cB + hstep + kstep, voffB);
        PG8_WAIT_V(6); PG8_BAR;
    }
    for (;;) {
        const bool has_next = S.next(ui + 1, nxt);
        const char* nA = has_next ? (const char*)g.A + (size_t)nxt.pm * tstep : cA; const char* nB = has_next ? (const char*)g.Bt + (size_t)nxt.pn * tstep : cB;
        for (int t = 0; t < nt; t += 2) {
            const bool last = (t == nt - 2);
            const char* a1 = cA + (size_t)(t + 1) * kstep;
            const char* a2 = last ? nA : cA + (size_t)(t + 2) * kstep; const char* b2 = last ? nB : cB + (size_t)(t + 2) * kstep;
            const char* a3 = a2 + kstep; const char* b3 = b2 + kstep;
            if (last && has_next) S.a_ready(nxt);
            if constexpr (SP2) {
            PG8_LDB(B0, 0, 0); PG8_LDB(B1, 0, 1); PG8_SCHED; PG8_LDA(At, 0, 0); PG8_STAGE(PG8_SA(1, 1), a1 + hstep, voffA);
            PG8_WAIT_V(8); PG8_WAIT_L(0); PG8_BAR; PG8_MMA(0, 0, At, B0); PG8_MMA(0, 1, At, B1); PG8_BAR; PG8_SCHED;
            PG8_LDA(At, 0, 1); PG8_STAGE(PG8_SB(0, 0), b2, voffB); PG8_STAGE(PG8_SB(0, 1), b2 + hstep, voffB); PG8_STAGE(PG8_SA(0, 0), a2, voffA);
            PG8_WAIT_V(8); PG8_WAIT_L(0); PG8_BAR; PG8_MMA(1, 0, At, B0); PG8_MMA(1, 1, At, B1); PG8_BAR; PG8_SCHED;
            PG8_LDB(B0, 1, 0); PG8_LDB(B1, 1, 1); PG8_SCHED; PG8_LDA(At, 1, 0); PG8_STAGE(PG8_SA(0, 1), a2 + hstep, voffA);
            PG8_WAIT_V(8); PG8_WAIT_L(0); PG8_BAR; PG8_MMA(0, 0, At, B0); PG8_MMA(0, 1, At, B1); PG8_BAR; PG8_SCHED;
            PG8_LDA(At, 1, 1); PG8_STAGE(PG8_SB(1, 0), b3, voffB); PG8_STAGE(PG8_SB(1, 1), b3 + hstep, voffB); PG8_STAGE(PG8_SA(1, 0), a3, voffA);
            PG8_WAIT_V(8); PG8_WAIT_L(0); PG8_BAR; PG8_MMA(1, 0, At, B0); PG8_MMA(1, 1, At, B1); PG8_BAR; PG8_SCHED;
            } else {
            PG8_LDB(B0, 0, 0); PG8_SCHED; PG8_LDA(At, 0, 0); PG8_STAGE(PG8_SA(1, 1), a1 + hstep, voffA);
            PG8_WAIT_L(8); PG8_BAR; PG8_WAIT_L(0); PG8_MMA(0, 0, At, B0); PG8_BAR; PG8_SCHED;
            PG8_LDB(B1, 0, 1); PG8_STAGE(PG8_SB(0, 0), b2, voffB);
            PG8_BAR; PG8_WAIT_L(0); PG8_MMA(0, 1, At, B1); PG8_BAR;
            PG8_LDA(At, 0, 1); PG8_STAGE(PG8_SA(0, 0), a2, voffA);
            PG8_BAR; PG8_WAIT_L(0); PG8_MMA(1, 0, At, B0); PG8_BAR; PG8_SCHED;
            PG8_STAGE(PG8_SB(0, 1), b2 + hstep, voffB);
            PG8_WAIT_V(6); PG8_BAR; PG8_MMA(1, 1, At, B1); PG8_BAR;
            PG8_LDB(B0, 1, 0); PG8_SCHED; PG8_LDA(At, 1, 0); PG8_STAGE(PG8_SA(0, 1), a2 + hstep, voffA);
            PG8_WAIT_L(8); PG8_BAR; PG8_WAIT_L(0); PG8_MMA(0, 0, At, B0); PG8_BAR; PG8_SCHED;
            PG8_LDB(B1, 1, 1); PG8_STAGE(PG8_SB(1, 0), b3, voffB);
            PG8_BAR; PG8_WAIT_L(0); PG8_MMA(0, 1, At, B1); PG8_BAR;
            PG8_LDA(At, 1, 1); PG8_STAGE(PG8_SA(1, 0), a3, voffA);
            PG8_BAR; PG8_WAIT_L(0); PG8_MMA(1, 0, At, B0); PG8_BAR; PG8_SCHED;
            PG8_STAGE(PG8_SB(1, 1), b3 + hstep, voffB);
            PG8_WAIT_V(6); PG8_BAR; PG8_MMA(1, 1, At, B1); PG8_BAR;
            }
        }
        if constexpr (ALIGN_EPI) { if (wr == 0) PG8_BAR; }
        { int fr_e = fr, fq_e = fq; asm volatile("" : "+v"(fr_e), "+v"(fq_e)); E(acc, cur, wr, wc, fr_e, fq_e); }
        S.done(cur);
        if (!has_next) break;
#pragma unroll
        for (int a = 0; a < 2; ++a)
#pragma unroll
            for (int b = 0; b < 2; ++b)
#pragma unroll
                for (int m = 0; m < 4; ++m)
#pragma unroll
                    for (int n = 0; n < 2; ++n) acc[a][b][m][n] = (f32x4){0.f, 0.f, 0.f, 0.f};
        cur = nxt; cA = nA; cB = nB; ++ui;
        if constexpr (ALIGN_EPI) { if (wr == 1) PG8_BAR; }
    }
    PG8_WAIT_V(0);
    if constexpr (!ALIGN_EPI) { if (wr == 0) PG8_BAR; }
    PG8_BAR;
#undef PG8_SA
#undef PG8_SB
#undef PG8_STAGE
#undef PG8_LDA
#undef PG8_LDB
#undef PG8_MMA
#undef PG8_WAIT_V
#undef PG8_WAIT_L
#undef PG8_BAR
#undef PG8_SCHED
}

struct EpiSwiGLU {
    static constexpr bool PERM = true;
    bf16_t* H; const float* SS; const float* bias;
    __device__ __forceinline__ void operator()(const f32x4 (&acc)[2][2][4][2], const Unit& u, int wr, int wc, int fr, int fq) const {
        const int mi = mod_index_of_tile(u.pm);
        const float* bp = bias + (size_t)mi * NFF + u.pn * 256 + wc * 32 + 8 * fq;
        f32x4 bv[2][2];
#pragma unroll
        for (int bj = 0; bj < 2; ++bj)
#pragma unroll
            for (int n = 0; n < 2; ++n) bv[bj][n] = *(const f32x4*)(bp + bj * 128 + 4 * n);
        const int row0 = u.pm * 256 + wr * 64 + fr;
        float rsv[2][4]; row_rstd16x8(SS, row0, fq, rsv);
#pragma unroll
        for (int ai = 0; ai < 2; ++ai)
#pragma unroll
            for (int m = 0; m < 4; ++m) {
                const int row = row0 + ai * 128 + m * 16;
                const float rs = rsv[ai][m];
                float h[8];
#pragma unroll
                for (int n = 0; n < 2; ++n) {
                    const f32x4 a = acc[ai][0][m][n] * rs + bv[0][n], b = acc[ai][1][m][n] * rs + bv[1][n];
                    const f32x4 t = a * -1.4426950408889634f;
                    f32x4 e; e.x = __builtin_amdgcn_exp2f(t.x); e.y = __builtin_amdgcn_exp2f(t.y); e.z = __builtin_amdgcn_exp2f(t.z); e.w = __builtin_amdgcn_exp2f(t.w);
                    const f32x4 d = e + 1.0f;
                    f32x4 r; r.x = fast_rcp(d.x); r.y = fast_rcp(d.y); r.z = fast_rcp(d.z); r.w = fast_rcp(d.w);
                    const f32x4 hv = (a * r) * b;
                    h[n * 4 + 0] = hv.x; h[n * 4 + 1] = hv.y; h[n * 4 + 2] = hv.z; h[n * 4 + 3] = hv.w;
                }
                u32x4 w; w.x = cvt_pk_bf16(h[0], h[1]); w.y = cvt_pk_bf16(h[2], h[3]); w.z = cvt_pk_bf16(h[4], h[5]); w.w = cvt_pk_bf16(h[6], h[7]);
                *(u32x4*)(H + (size_t)row * DFF + u.pn * 128 + wc * 32 + 8 * fq) = w;
            }
    }
};

struct EpiResid {
    static constexpr bool PERM = true;
    const float* xin_lat; const float* xin_ctx; const bf16_t* xin_bf; bf16_t* xout_bf; float* xout_f32; const float* gate; const float* gsn; bf16_t* AH; float* SS; float fac; int pad;
    template <bool IN_F32> __device__ __forceinline__ void body(const f32x4 (&acc)[2][2][4][2], const Unit& u, int wr, int wc, int fr, int fq) const {
        const int mi = mod_index_of_tile(u.pm);
        const int col0 = u.pn * 256 + wc * 32 + 8 * fq;
        f32x4 gv[2][2], sv[2][2];
#pragma unroll
        for (int bj = 0; bj < 2; ++bj)
#pragma unroll
            for (int n = 0; n < 2; ++n) {
                gv[bj][n] = *(const f32x4*)(gate + (size_t)mi * NMOD + col0 + bj * 128 + 4 * n) * fac;
                sv[bj][n] = gsn ? *(const f32x4*)(gsn + (size_t)mi * DM + col0 + bj * 128 + 4 * n) : (f32x4){0.f, 0.f, 0.f, 0.f};
            }
        const int row0 = u.pm * 256 + wr * 64 + fr;
        constexpr int NBUF = 3;
        f32x4 xf[IN_F32 ? NBUF : 1][2][2];
        u32x4 xb[IN_F32 ? 1 : NBUF][2];
#define RES_LOAD(g, buf) do { const int row_ = row0 + ((g) >> 2) * 128 + ((g) & 3) * 16; \
            if constexpr (IN_F32) { const float* xp_ = (row_ < ML) ? xin_lat + (size_t)row_ * DM : xin_ctx + (size_t)(row_ - ML) * DM; \
                _Pragma("unroll") for (int bj = 0; bj < 2; ++bj) { xf[buf][bj][0] = *(const f32x4*)(xp_ + col0 + bj * 128); xf[buf][bj][1] = *(const f32x4*)(xp_ + col0 + bj * 128 + 4); } } \
            else { _Pragma("unroll") for (int bj = 0; bj < 2; ++bj) xb[buf][bj] = *(const u32x4*)(xin_bf + (size_t)row_ * DM + col0 + bj * 128); } } while (0)
#pragma unroll
        for (int g = 0; g < NBUF - 1; ++g) RES_LOAD(g, g);
#pragma unroll
        for (int g = 0; g < 8; ++g) {
            const int ai = g >> 2, m = g & 3;
            if (g + NBUF - 1 < 8) RES_LOAD(g + NBUF - 1, (g + NBUF - 1) % NBUF);
            const int row = row0 + ai * 128 + m * 16;
            float ssq = 0.f;
#pragma unroll
            for (int bj = 0; bj < 2; ++bj) {
                f32x4 x0, x1;
                if constexpr (IN_F32) { x0 = xf[g % NBUF][bj][0]; x1 = xf[g % NBUF][bj][1]; }
                else { const u32x4 w = xb[g % NBUF][bj]; const f32x2 p0 = unpk_h2(w.x), p1 = unpk_h2(w.y), p2 = unpk_h2(w.z), p3 = unpk_h2(w.w); x0 = (f32x4){p0.x, p0.y, p1.x, p1.y}; x1 = (f32x4){p2.x, p2.y, p3.x, p3.y}; }
                const f32x4 y0 = x0 + gv[bj][0] * acc[ai][bj][m][0], y1 = x1 + gv[bj][1] * acc[ai][bj][m][1];
                if (xout_f32) { float* op = xout_f32 + (size_t)row * DM; *(f32x4*)(op + col0 + bj * 128) = y0; *(f32x4*)(op + col0 + bj * 128 + 4) = y1; }
                else { u32x4 w; w.x = pk_h2(y0.x, y0.y); w.y = pk_h2(y0.z, y0.w); w.z = pk_h2(y1.x, y1.y); w.w = pk_h2(y1.z, y1.w);
                    *(u32x4*)(xout_bf + (size_t)row * DM + col0 + bj * 128) = w; }
                ssq += (y0.x * y0.x + y0.y * y0.y) + (y0.z * y0.z + y0.w * y0.w) + (y1.x * y1.x + y1.y * y1.y) + (y1.z * y1.z + y1.w * y1.w);
                if (gsn) {
                    const f32x4 a0 = y0 * sv[bj][0], a1 = y1 * sv[bj][1];
                    u32x4 w; w.x = cvt_pk_bf16(a0.x, a0.y); w.y = cvt_pk_bf16(a0.z, a0.w); w.z = cvt_pk_bf16(a1.x, a1.y); w.w = cvt_pk_bf16(a1.z, a1.w);
                    *(u32x4*)(AH + (size_t)row * DM + col0 + bj * 128) = w;
                }
            }
            if (gsn) {
                ssq += __shfl_xor(ssq, 16); ssq += __shfl_xor(ssq, 32);
                if (fq == 0) SS[(size_t)row * 16 + u.pn * 4 + wc] = ssq;
            }
        }
#undef RES_LOAD
    }
    __device__ __forceinline__ void operator()(const f32x4 (&acc)[2][2][4][2], const Unit& u, int wr, int wc, int fr, int fq) const {
        if (xin_bf) body<false>(acc, u, wr, wc, fr, fq); else body<true>(acc, u, wr, wc, fr, fq);
    }
};

struct EpiInA {
    static constexpr bool PERM = false;
    const float* SS; const float* bias; const float* qkg; const float* rope; bf16_t* Q; bf16_t* KB; bf16_t* VB; bf16_t* P;
    __device__ __forceinline__ void operator()(const f32x4 (&acc)[2][2][4][2], const Unit& u, int wr, int wc, int fr, int fq) const {
        const int mi = mod_index_of_tile(u.pm);
        const int row0 = u.pm * 256 + wr * 64 + fr;
        float rsv[2][4]; row_rstd16x8(SS, row0, fq, rsv);
        asm volatile("" : "+v"(rsv[0][0]), "+v"(rsv[0][1]), "+v"(rsv[0][2]), "+v"(rsv[0][3]), "+v"(rsv[1][0]), "+v"(rsv[1][1]), "+v"(rsv[1][2]), "+v"(rsv[1][3]) :: "memory");
        const float* bp = bias + (size_t)mi * NFF + u.pn * 256 + wc * 32 + 4 * fq;
        f32x4 bv[2][2];
#pragma unroll
        for (int bj = 0; bj < 2; ++bj)
#pragma unroll
            for (int n = 0; n < 2; ++n) bv[bj][n] = *(const f32x4*)(bp + bj * 128 + 16 * n);
        if (u.pn >= 3) {
#pragma unroll
            for (int ai = 0; ai < 2; ++ai)
#pragma unroll
                for (int m = 0; m < 4; ++m) {
                    const int row = row0 + ai * 128 + m * 16;
                    const float rs = rsv[ai][m];
                    bf16_t* pp = P + (size_t)row * 512 + (u.pn - 3) * 256 + wc * 32 + 4 * fq;
#pragma unroll
                    for (int bj = 0; bj < 2; ++bj)
#pragma unroll
                        for (int n = 0; n < 2; ++n) { const f32x4 v = acc[ai][bj][m][n] * rs + bv[bj][n]; u32x2 w; w.x = cvt_pk_bf16(v.x, v.y); w.y = cvt_pk_bf16(v.z, v.w); *(u32x2*)(pp + bj * 128 + 16 * n) = w; }
                }
            return;
        }
        const bool isv = (u.pn == 2 && wc >= 2), isk = (u.pn == 2 && wc < 2);
        const int head = (u.pn < 2) ? (u.pn * 4 + wc) : (wc & 1);
        f32x4 gq[2][2];
#pragma unroll
        for (int bj = 0; bj < 2; ++bj)
#pragma unroll
            for (int n = 0; n < 2; ++n) gq[bj][n] = *(const f32x4*)(qkg + (isk ? 64 : 0) + 32 * bj + 16 * n + 4 * fq);
#pragma unroll
        for (int ai = 0; ai < 2; ++ai)
#pragma unroll
            for (int m = 0; m < 4; ++m) {
                const int row = row0 + ai * 128 + m * 16;
                const float rs = rsv[ai][m];
                f32x4 v[2][2];
#pragma unroll
                for (int bj = 0; bj < 2; ++bj)
#pragma unroll
                    for (int n = 0; n < 2; ++n) v[bj][n] = acc[ai][bj][m][n] * rs + bv[bj][n];
                const bool lat = row < ML;
                const int kvb = lat ? (row >> 13) : ((row - ML) >> 8), kvi = lat ? (CTXL + (row & 8191)) : ((row - ML) & 255);
                if (!isv) {
                    float ss = 0.f;
#pragma unroll
                    for (int bj = 0; bj < 2; ++bj)
#pragma unroll
                        for (int n = 0; n < 2; ++n) ss += (v[bj][n].x * v[bj][n].x + v[bj][n].y * v[bj][n].y) + (v[bj][n].z * v[bj][n].z + v[bj][n].w * v[bj][n].w);
                    ss += __shfl_xor(ss, 16); ss += __shfl_xor(ss, 32);
                    const float r = 1.0f / sqrtf(ss * (1.0f / 64.0f) + EPS);
#pragma unroll
                    for (int bj = 0; bj < 2; ++bj)
#pragma unroll
                        for (int n = 0; n < 2; ++n) v[bj][n] = v[bj][n] * r * gq[bj][n];
                    if (lat) {
                        const int t = row & 8191;
#pragma unroll
                        for (int bj = 0; bj < 2; ++bj) {
                            const int pos = bj == 0 ? (t >> 6) : (t & 63);
                            const f32x4 cs0 = *(const f32x4*)(rope + (size_t)pos * 32 + 8 * fq), cs1 = *(const f32x4*)(rope + (size_t)pos * 32 + 8 * fq + 4);
                            const f32x4 c = (f32x4){cs0.x, cs0.z, cs1.x, cs1.z}, s = (f32x4){cs0.y, cs0.w, cs1.y, cs1.w};
                            const f32x4 x1 = v[bj][0], x2 = v[bj][1];
                            v[bj][0] = x1 * c - x2 * s; v[bj][1] = x1 * s + x2 * c;
                        }
                    }
                    if (!isk) {
#pragma unroll
                        for (int bj = 0; bj < 2; ++bj)
#pragma unroll
                            for (int n = 0; n < 2; ++n) v[bj][n] = v[bj][n] * QSCALE;
                    }
                }
                bf16_t* dst = (u.pn < 2) ? (Q + (size_t)row * 512 + head * 64) : ((isk ? KB : VB) + ((size_t)(kvb * 2 + head) * KVROWS + kvi) * 64);
                dst += 4 * fq;
#pragma unroll
                for (int bj = 0; bj < 2; ++bj)
#pragma unroll
                    for (int n = 0; n < 2; ++n) { u32x2 w; w.x = cvt_pk_bf16(v[bj][n].x, v[bj][n].y); w.y = cvt_pk_bf16(v[bj][n].z, v[bj][n].w); *(u32x2*)(dst + 32 * bj + 16 * n) = w; }
            }
    }
};

struct EpiInC {
    static constexpr bool PERM = true;
    const float* SS; const float* bias; bf16_t* U; bf16_t* V; float* VSS;
    __device__ __forceinline__ void operator()(const f32x4 (&acc)[2][2][4][2], const Unit& u, int wr, int wc, int fr, int fq) const {
        const int mi = mod_index_of_tile(u.pm);
        const float* bp = bias + (size_t)mi * NFF + u.pn * 256 + wc * 32 + 8 * fq;
        f32x4 bv[2][2];
#pragma unroll
        for (int bj = 0; bj < 2; ++bj)
#pragma unroll
            for (int n = 0; n < 2; ++n) bv[bj][n] = *(const f32x4*)(bp + bj * 128 + 4 * n);
        const int row0 = u.pm * 256 + wr * 64 + fr;
        const bool isv = u.pn >= 4;
        bf16_t* base = isv ? V : U;
        const int ctile = (u.pn & 3) * 256 + wc * 32 + 8 * fq;
        float rsv[2][4]; row_rstd16x8(SS, row0, fq, rsv);
#pragma unroll
        for (int ai = 0; ai < 2; ++ai)
#pragma unroll
            for (int m = 0; m < 4; ++m) {
                const int row = row0 + ai * 128 + m * 16;
                const float rs = rsv[ai][m];
                float ssq = 0.f;
#pragma unroll
                for (int bj = 0; bj < 2; ++bj) {
                    float z[8];
#pragma unroll
                    for (int n = 0; n < 2; ++n)
#pragma unroll
                        for (int j = 0; j < 4; ++j) { z[n * 4 + j] = gelu_tanh_f(acc[ai][bj][m][n][j] * rs + bv[bj][n][j]); ssq += z[n * 4 + j] * z[n * 4 + j]; }
                    u32x4 w; w.x = cvt_pk_bf16(z[0], z[1]); w.y = cvt_pk_bf16(z[2], z[3]); w.z = cvt_pk_bf16(z[4], z[5]); w.w = cvt_pk_bf16(z[6], z[7]);
                    *(u32x4*)(base + (size_t)row * DM + ctile + bj * 128) = w;
                }
                if (isv) {
                    ssq += __shfl_xor(ssq, 16); ssq += __shfl_xor(ssq, 32);
                    if (fq == 0) VSS[(size_t)row * 16 + (u.pn - 4) * 4 + wc] = ssq;
                }
            }
    }
};
}

namespace attn_body {
using bf16 = __hip_bfloat16;
using s16x4 = __attribute__((ext_vector_type(4))) short;
using f32x16 = __attribute__((ext_vector_type(16))) float;
constexpr int D = 64, NW = 8, QBLK = 32, QB = QBLK * NW, KVBLK = 64;
constexpr int QP = 512, KVP = 64, OP = 1024;
__device__ __forceinline__ int crow(int r, int hi) { return (r & 3) + 8 * (r >> 2) + 4 * hi; }
#define SBAR() __builtin_amdgcn_sched_barrier(0)
constexpr int NSLOT = 3, SLOTB = 8192;
constexpr int LDS_K = 0, LDS_V = NSLOT * SLOTB, LDS_WS = 2 * NSLOT * SLOTB, LDS_OST = LDS_WS + NW * 64 * 4, LDS_BYTES_A = LDS_OST + NW * 4096;
__device__ __forceinline__ void glds16(const void* gsrc, unsigned lds_dst) { unsigned keep;
    asm volatile("s_mov_b32 %0, m0\n\ts_mov_b32 m0, %2\n\ts_nop 0\n\tglobal_load_lds_dwordx4 %1, off\n\ts_mov_b32 m0, %0" : "=&s"(keep) : "v"(gsrc), "s"(lds_dst) : "memory"); }
__device__ __forceinline__ float max3f(float a, float b, float c) { float r; asm("v_max3_f32 %0, %1, %2, %3" : "=v"(r) : "v"(a), "v"(b), "v"(c)); return r; }
__device__ __forceinline__ float max2f(float a, float b) { float r; asm("v_max_f32_e32 %0, %1, %2" : "=v"(r) : "v"(a), "v"(b)); return r; }
__device__ __forceinline__ float fadd_s(float a, float b) { float r; asm("v_add_f32_e32 %0, %1, %2" : "=v"(r) : "v"(a), "v"(b)); return r; }
__device__ __forceinline__ float fsub_s(float a, float b) { float r; asm("v_sub_f32_e32 %0, %1, %2" : "=v"(r) : "v"(a), "v"(b)); return r; }
typedef float f32x2_t __attribute__((ext_vector_type(2))); typedef __bf16 bf16x2_t __attribute__((ext_vector_type(2)));
__device__ __forceinline__ unsigned cvtpk_s(float lo, float hi) { f32x2_t v = {lo, hi}; bf16x2_t b = __builtin_convertvector(v, bf16x2_t); return __builtin_bit_cast(unsigned, b); }
#define WAIT_BAR(N) asm volatile("s_waitcnt vmcnt(" #N ") lgkmcnt(0)\n\ts_barrier" ::: "memory")
__device__ __forceinline__ void qkt(f32x16& p0, f32x16& p1, const char* Kslot, const bf16x8* qr, const f32x16& negm, int r32, int hi) {
    const char* kb = Kslot + hi * 1024 + r32 * 16;
#pragma unroll
    for (int d0 = 0; d0 < 4; ++d0) {
        const bf16x8 b0 = *reinterpret_cast<const bf16x8*>(kb + d0 * 2048);
        const bf16x8 b1 = *reinterpret_cast<const bf16x8*>(kb + d0 * 2048 + 512);
        if (d0 == 0) { p0 = __builtin_amdgcn_mfma_f32_32x32x16_bf16(b0, qr[0], negm, 0, 0, 0); p1 = __builtin_amdgcn_mfma_f32_32x32x16_bf16(b1, qr[0], negm, 0, 0, 0); }
        else { p0 = __builtin_amdgcn_mfma_f32_32x32x16_bf16(b0, qr[d0], p0, 0, 0, 0); p1 = __builtin_amdgcn_mfma_f32_32x32x16_bf16(b1, qr[d0], p1, 0, 0, 0); } }
}
typedef __attribute__((address_space(3))) const char* lds_cptr;
typedef short v4i16_t __attribute__((ext_vector_type(4)));
__device__ __forceinline__ void kload8(bf16x8* kf, lds_cptr kp) {
    kf[0] = *(const LAS bf16x8*)(kp);        kf[1] = *(const LAS bf16x8*)(kp + 512);
    kf[2] = *(const LAS bf16x8*)(kp + 2048); kf[3] = *(const LAS bf16x8*)(kp + 2560);
    kf[4] = *(const LAS bf16x8*)(kp + 4096); kf[5] = *(const LAS bf16x8*)(kp + 4608);
    kf[6] = *(const LAS bf16x8*)(kp + 6144); kf[7] = *(const LAS bf16x8*)(kp + 6656);
}
__device__ __forceinline__ void kload2(bf16x8* kf, lds_cptr kp, int j) { kf[2 * j] = *(const LAS bf16x8*)(kp + j * 2048); kf[2 * j + 1] = *(const LAS bf16x8*)(kp + j * 2048 + 512); }
__device__ __forceinline__ s16x4 vtr(lds_cptr p) { return __builtin_bit_cast(s16x4, __builtin_amdgcn_ds_read_tr16_b64_v4i16((LAS v4i16_t*)p)); }
__device__ __forceinline__ float rowmax(const f32x16& p0, const f32x16& p1) {
    float a = max3f(p0[0], p0[1], p1[0]), b = max3f(p0[2], p0[3], p1[1]); a = max3f(a, p1[2], p1[3]);
#pragma unroll
    for (int r = 4; r < 16; r += 4) { a = max3f(a, p0[r], p0[r + 1]); b = max3f(b, p0[r + 2], p0[r + 3]); a = max3f(a, p1[r], p1[r + 1]); b = max3f(b, p1[r + 2], p1[r + 3]); }
    const float m = max2f(a, b);
    auto rr = __builtin_amdgcn_permlane32_swap(__float_as_uint(m), __float_as_uint(m), false, false);
    return max2f(__uint_as_float(rr[0]), __uint_as_float(rr[1]));
}
__device__ __forceinline__ void pv(f32x16* o, int vb, bf16x8 pa0, bf16x8 pa1, bf16x8 pa2, bf16x8 pa3) {
#pragma unroll
    for (int d0 = 0; d0 < 2; ++d0) { s16x4 lo[4], hi[4];
#pragma unroll
        for (int ks = 0; ks < 4; ++ks) {
            asm volatile("ds_read_b64_tr_b16 %0,%1 offset:%c2" : "=&v"(lo[ks]) : "v"(vb), "i"(d0 * 4096 + ks * 1024) : "memory");
            asm volatile("ds_read_b64_tr_b16 %0,%1 offset:%c2" : "=&v"(hi[ks]) : "v"(vb), "i"(d0 * 4096 + ks * 1024 + 512) : "memory"); }
        asm volatile("s_waitcnt lgkmcnt(0)" ::: "memory"); SBAR();
#define PK(k) (bf16x8){lo[k][0], lo[k][1], lo[k][2], lo[k][3], hi[k][0], hi[k][1], hi[k][2], hi[k][3]}
        o[d0] = __builtin_amdgcn_mfma_f32_32x32x16_bf16(pa0, PK(0), o[d0], 0, 0, 0);
        o[d0] = __builtin_amdgcn_mfma_f32_32x32x16_bf16(pa1, PK(1), o[d0], 0, 0, 0);
        o[d0] = __builtin_amdgcn_mfma_f32_32x32x16_bf16(pa2, PK(2), o[d0], 0, 0, 0);
        o[d0] = __builtin_amdgcn_mfma_f32_32x32x16_bf16(pa3, PK(3), o[d0], 0, 0, 0);
#undef PK
    }
}

template <int THRL> __device__ __forceinline__ void attn_unit(const bf16* Qu, const bf16* __restrict__ Kh, const bf16* __restrict__ Vh, const int NT, bf16* Ou, char* shm) {
    int tid_ = threadIdx.x; asm volatile("" : "+v"(tid_));
    const int tid = tid_, lane = tid & 63, r32 = lane & 31, hi = lane >> 5; const int wid = __builtin_amdgcn_readfirstlane(tid >> 6);
    const bf16* Qw = Qu + (long)(wid * QBLK) * QP;
    const unsigned lds0 = (unsigned)(uintptr_t)shm;
    float* wsf = (float*)(shm + LDS_WS) + wid * 64;
    const bf16* ksrc = Kh + (long)lane * KVP + wid * 8;
    const bf16* vsrc = Vh + (long)(16 * (wid & 3) + (lane >> 2)) * KVP + (wid >> 2) * 32 + (lane & 3) * 8;
    const unsigned kdst = lds0 + LDS_K + wid * 1024, vdst = lds0 + LDS_V + wid * 1024;
#define DMA_K(t, slot) glds16(ksrc + (long)(t) * KVBLK * KVP, (unsigned)__builtin_amdgcn_readfirstlane(kdst + (slot)))
#define DMA_V(t, slot) glds16(vsrc + (long)(t) * KVBLK * KVP, (unsigned)__builtin_amdgcn_readfirstlane(vdst + (slot)))
    const int vb0 = (int)(lds0 + LDS_V) + ((lane >> 4) & 1) * 32 + (lane & 3) * 8 + (4 * hi + ((lane & 15) >> 2)) * 64;
    const char* Kbase = shm + LDS_K; bf16x8 kf[8];
    const lds_cptr shm3 = (lds_cptr)shm; const lds_cptr kp0 = shm3 + LDS_K + hi * 1024 + r32 * 16; const lds_cptr vp0 = shm3 + LDS_V + ((lane >> 4) & 1) * 32 + (lane & 3) * 8 + (4 * hi + ((lane & 15) >> 2)) * 64;
    DMA_K(0, 0); DMA_V(0, 0); DMA_K(1, SLOTB);
    bf16x8 qr[4];
#pragma unroll
    for (int d0 = 0; d0 < 4; ++d0) qr[d0] = *reinterpret_cast<const bf16x8*>(&Qw[(long)r32 * QP + d0 * 16 + hi * 8]);
    float mhat = 0.f, l_reg = 0.f; f32x16 o[2]; o[0] = f32x16{}; o[1] = f32x16{}; f32x16 negm = f32x16{}; asm volatile("" : "+v"(negm));
    bool resc = false;
#define START(P0, P1) do { const float rm = rowmax(P0, P1); resc = false; \
    { const float dl = rm; mhat = fadd_s(mhat, dl); \
      _Pragma("unroll") for (int r = 0; r < 16; ++r) { P0[r] = fsub_s(P0[r], dl); P1[r] = fsub_s(P1[r], dl); } \
      _Pragma("unroll") for (int r = 0; r < 16; ++r) negm[r] = -mhat; asm volatile("" : "+v"(negm)); } \
    _Pragma("unroll") for (int r = 0; r < 16; ++r) P0[r] = __builtin_amdgcn_exp2f(P0[r]); } while (0)
#define RESC() do { if (resc) { asm volatile("s_waitcnt lgkmcnt(0)" ::: "memory"); \
      _Pragma("unroll") for (int d_ = 0; d_ < 2; ++d_) _Pragma("unroll") for (int r = 0; r < 16; ++r) o[d_][r] *= wsf[crow(r, hi)]; } } while (0)
    f32x16 pA0, pA1, pB0, pB1;
    int sl_prev = 0, sl_cur = 0, sl_next = SLOTB;
#define ROT() do { sl_prev = sl_cur; sl_cur = sl_next; sl_next = (sl_next == (NSLOT - 1) * SLOTB) ? 0 : sl_next + SLOTB; } while (0)
    DMA_K(2, 2 * SLOTB);
    WAIT_BAR(3);
    qkt(pA0, pA1, Kbase, qr, negm, r32, hi); asm volatile("s_nop 15\n\ts_nop 7" : "+v"(pA0), "+v"(pA1));
    START(pA0, pA1);
    _Pragma("unroll") for (int r = 0; r < 16; ++r) pA1[r] = __builtin_amdgcn_exp2f(pA1[r]);
    WAIT_BAR(0);
    DMA_K(3, 0); DMA_V(1, SLOTB);
    ROT();
    kload8(kf, kp0 + sl_cur);
    WAIT_BAR(2);
    s16x4 vlo[8], vhi[8]; u32x4 pw0, pw1, pw2, pw3;
#define PKW(P, B) cvtpk_s(P[B], P[B + 1])
#define PAF(k) __builtin_bit_cast(bf16x8, pw##k)
#define VFR(i) (bf16x8){vlo[i][0], vlo[i][1], vlo[i][2], vlo[i][3], vhi[i][0], vhi[i][1], vhi[i][2], vhi[i][3]}
#define PIN(x) asm volatile("" : "+v"(x))
#define MX3(a, b, c) __builtin_fmaxf(__builtin_fmaxf((a), (b)), (c))
#define GAPA(MF, A0, A1, A2, A3, W0, W1, PW) do { MF; sacc += A0; sacc += A1; sacc += A2; sacc += A3; PIN(sacc); W0; W1; PIN(PW); SBAR(); } while (0)
#define EX(v) __builtin_amdgcn_exp2f(v)
#define GAPB(MF, X, B) do { MF; X[B] = EX(X[B]); X[B + 1] = EX(X[B + 1]); X[B + 2] = EX(X[B + 2]); X[B + 3] = EX(X[B + 3]); PIN(X); SBAR(); } while (0)
#define VRD(i) do { vlo[i] = vtr(vp_ + (((i) >> 2) * 4096 + ((i) & 3) * 1024)); vhi[i] = vtr(vp_ + (((i) >> 2) * 4096 + ((i) & 3) * 1024 + 512)); } while (0)
#define KRD(G, j) do { if (G) { kload2(kf, kp0 + sl_next, j); SBAR(); } } while (0)
#define STEP(C0, C1, P0, P1, t, GK, GV, GL, CHK) do { SBAR(); \
    const lds_cptr vp_ = vp0 + sl_prev; \
    VRD(0); SBAR(); float sacc = (P0[0] + P0[1]); \
    GAPA(C0 = __builtin_amdgcn_mfma_f32_32x32x16_bf16(kf[0], qr[0], negm, 0, 0, 0), P0[2], P0[3], P0[4], P0[5],     pw0[0] = PKW(P0, 0), pw0[1] = PKW(P0, 2), pw0); \
    VRD(4); SBAR(); GAPA(C1 = __builtin_amdgcn_mfma_f32_32x32x16_bf16(kf[1], qr[0], negm, 0, 0, 0), P0[6], P0[7], P0[8], P0[9],     pw0[2] = PKW(P0, 4), pw0[3] = PKW(P0, 6), pw0); \
    VRD(1); SBAR(); GAPA(C0 = __builtin_amdgcn_mfma_f32_32x32x16_bf16(kf[2], qr[1], C0, 0, 0, 0),   P0[10], P0[11], P0[12], P0[13], pw1[0] = PKW(P0, 8), pw1[1] = PKW(P0, 10), pw1); \
    VRD(5); SBAR(); GAPA(C1 = __builtin_amdgcn_mfma_f32_32x32x16_bf16(kf[3], qr[1], C1, 0, 0, 0),   P0[14], P0[15], P1[0], P1[1],   pw1[2] = PKW(P0, 12), pw1[3] = PKW(P0, 14), pw1); \
    VRD(2); SBAR(); GAPA(C0 = __builtin_amdgcn_mfma_f32_32x32x16_bf16(kf[4], qr[2], C0, 0, 0, 0),   P1[2], P1[3], P1[4], P1[5],     pw2[0] = PKW(P1, 0), pw2[1] = PKW(P1, 2), pw2); \
    VRD(6); SBAR(); GAPA(C1 = __builtin_amdgcn_mfma_f32_32x32x16_bf16(kf[5], qr[2], C1, 0, 0, 0),   P1[6], P1[7], P1[8], P1[9],     pw2[2] = PKW(P1, 4), pw2[3] = PKW(P1, 6), pw2); \
    VRD(3); SBAR(); GAPA(C0 = __builtin_amdgcn_mfma_f32_32x32x16_bf16(kf[6], qr[3], C0, 0, 0, 0),   P1[10], P1[11], P1[12], P1[13], pw3[0] = PKW(P1, 8), pw3[1] = PKW(P1, 10), pw3); \
    VRD(7); SBAR(); GAPA(C1 = __builtin_amdgcn_mfma_f32_32x32x16_bf16(kf[7], qr[3], C1, 0, 0, 0),   P1[14], P1[15], 0.f, 0.f,       pw3[2] = PKW(P1, 12), pw3[3] = PKW(P1, 14), pw3); \
    l_reg += sacc; \
    if (GK) { DMA_K((t) + 3, sl_cur); } if (GV) { DMA_V((t) + 1, sl_next); } \
    resc = false; \
    if (CHK) { float a = MX3(C0[0], C0[1], C1[0]), b = MX3(C0[2], C0[3], C1[1]); a = MX3(a, C1[2], C1[3]); \
      _Pragma("unroll") for (int r = 4; r < 16; r += 4) { a = MX3(a, C0[r], C0[r + 1]); b = MX3(b, C0[r + 2], C0[r + 3]); a = MX3(a, C1[r], C1[r + 1]); b = MX3(b, C1[r + 2], C1[r + 3]); } \
      float rm = __builtin_fmaxf(a, b); { auto rr = __builtin_amdgcn_permlane32_swap(__float_as_uint(rm), __float_as_uint(rm), false, false); rm = __builtin_fmaxf(__uint_as_float(rr[0]), __uint_as_float(rr[1])); } \
      if (__builtin_expect(__any(rm > (float)THRL), 0)) { const float dl = __builtin_fmaxf(rm, 0.f); mhat += dl; \
        _Pragma("unroll") for (int r = 0; r < 16; ++r) { C0[r] -= dl; C1[r] -= dl; } \
        _Pragma("unroll") for (int r = 0; r < 16; ++r) negm[r] = -mhat; asm volatile("" : "+v"(negm)); \
        const float f = __builtin_amdgcn_exp2f(-dl); l_reg *= f; if (hi == 0) wsf[r32] = f; resc = true; } } \
    SBAR(); \
    GAPB(o[0] = __builtin_amdgcn_mfma_f32_32x32x16_bf16(PAF(0), VFR(0), o[0], 0, 0, 0), C0, 0); \
    GAPB(o[1] = __builtin_amdgcn_mfma_f32_32x32x16_bf16(PAF(0), VFR(4), o[1], 0, 0, 0), C0, 4); \
    KRD(GL, 0); GAPB(o[0] = __builtin_amdgcn_mfma_f32_32x32x16_bf16(PAF(1), VFR(1), o[0], 0, 0, 0), C0, 8); \
    KRD(GL, 1); GAPB(o[1] = __builtin_amdgcn_mfma_f32_32x32x16_bf16(PAF(1), VFR(5), o[1], 0, 0, 0), C0, 12); \
    KRD(GL, 2); GAPB(o[0] = __builtin_amdgcn_mfma_f32_32x32x16_bf16(PAF(2), VFR(2), o[0], 0, 0, 0), C1, 0); \
    KRD(GL, 3); GAPB(o[1] = __builtin_amdgcn_mfma_f32_32x32x16_bf16(PAF(2), VFR(6), o[1], 0, 0, 0), C1, 4); \
    GAPB(o[0] = __builtin_amdgcn_mfma_f32_32x32x16_bf16(PAF(3), VFR(3), o[0], 0, 0, 0), C1, 8); \
    GAPB(o[1] = __builtin_amdgcn_mfma_f32_32x32x16_bf16(PAF(3), VFR(7), o[1], 0, 0, 0), C1, 12); \
    } while (0)
    int t = 1;
    for (; t + 5 < NT; t += 2) {
        STEP(pB0, pB1, pA0, pA1, t, true, true, true, true);      WAIT_BAR(2); RESC(); ROT();
        STEP(pA0, pA1, pB0, pB1, t + 1, true, true, true, false); WAIT_BAR(2); RESC(); ROT();
    }
#define ENDW(tt) do { if ((tt) + 3 < NT) { WAIT_BAR(2); } else if ((tt) + 2 < NT) { WAIT_BAR(1); } else { WAIT_BAR(0); } } while (0)
    for (; t + 1 < NT; t += 2) {
        STEP(pB0, pB1, pA0, pA1, t, (t + 3 < NT), (t + 1 < NT), (t + 1 < NT), true);       ENDW(t);     RESC(); ROT();
        STEP(pA0, pA1, pB0, pB1, t + 1, (t + 4 < NT), (t + 2 < NT), (t + 2 < NT), true);   ENDW(t + 1); RESC(); ROT();
    }
    STEP(pB0, pB1, pA0, pA1, NT - 1, false, false, false, true); RESC();
    { float sacc = pB0[0] + pB0[1]; _Pragma("unroll") for (int r = 2; r < 16; ++r) sacc += pB0[r]; _Pragma("unroll") for (int r = 0; r < 16; ++r) sacc += pB1[r]; l_reg += sacc;
      pw0 = (u32x4){PKW(pB0, 0), PKW(pB0, 2), PKW(pB0, 4), PKW(pB0, 6)}; pw1 = (u32x4){PKW(pB0, 8), PKW(pB0, 10), PKW(pB0, 12), PKW(pB0, 14)}; pw2 = (u32x4){PKW(pB1, 0), PKW(pB1, 2), PKW(pB1, 4), PKW(pB1, 6)}; pw3 = (u32x4){PKW(pB1, 8), PKW(pB1, 10), PKW(pB1, 12), PKW(pB1, 14)};
      SBAR(); pv(o, vb0 + sl_cur, PAF(0), PAF(1), PAF(2), PAF(3)); }
#undef PKW
#undef PAF
#undef VFR
#undef PIN
#undef MX3
#undef GAPA
#undef GAPB
#undef EX
#undef VRD
#undef KRD
#undef STEP
#undef ENDW
    { auto rr = __builtin_amdgcn_permlane32_swap(__float_as_uint(l_reg), __float_as_uint(l_reg), false, false); l_reg = __uint_as_float(rr[0]) + __uint_as_float(rr[1]); }
    if (hi == 0) wsf[32 + r32] = l_reg; asm volatile("s_waitcnt lgkmcnt(0)" ::: "memory");
    float rli[16];
#pragma unroll
    for (int r = 0; r < 16; ++r) rli[r] = __builtin_amdgcn_rcpf(wsf[32 + crow(r, hi)]);
    bf16* Ow = Ou + (long)(wid * QBLK) * OP;
    { bf16* stg = (bf16*)(shm + LDS_OST) + wid * 2048;
#pragma unroll
      for (int r = 0; r < 16; ++r) { const int orow = crow(r, hi);
#pragma unroll
        for (int d0 = 0; d0 < 2; ++d0) stg[orow * 64 + d0 * 32 + r32] = __float2bfloat16(o[d0][r] * rli[r]); }
      asm volatile("s_waitcnt lgkmcnt(0)" ::: "memory");
#pragma unroll
      for (int i = 0; i < 4; ++i) { const int row = i * 8 + (lane >> 3), ch = lane & 7; const u32x4 v = *(const u32x4*)(stg + row * 64 + ch * 8); *(u32x4*)(Ow + (long)row * OP + ch * 8) = v; } }
    asm volatile("s_waitcnt lgkmcnt(0)\n\ts_barrier" ::: "memory");
#undef DMA_K
#undef DMA_V
#undef START
#undef RESC
#undef ROT
}
#undef SBAR
#undef WAIT_BAR
}

template <int KS> __device__ __forceinline__ void ctx_gemm_resid(LAS unsigned char* lds, const bf16_t* A, const bf16_t* Wt, const pg8::EpiResid& E, int tile) {
    int tid_ = threadIdx.x; asm volatile("" : "+v"(tid_));
    const int tid = tid_, lane = tid & 63, wave = __builtin_amdgcn_readfirstlane(tid >> 6), fr = lane & 15, fq = lane >> 4;
    constexpr int K = KS * 256;
    const int rt = tile >> 4, ct = tile & 15, row0 = ML + rt * 32, col0 = ct * 64;
    const bf16_t* ap = A + (size_t)(row0 + fr) * K + wave * (KS * 32) + 8 * fq;
    const bf16_t* bp = Wt + (size_t)(col0 + fr) * K + wave * (KS * 32) + 8 * fq;
    const int erow = row0 + (tid >> 4), ecol = col0 + 4 * (tid & 15);
    const f32x4 e_gate = *(const f32x4*)(E.gate + (size_t)2 * NMOD + ecol);
    f32x4 e_x;
    if (E.xin_bf) { const u32x2 w = *(const u32x2*)(E.xin_bf + (size_t)erow * DM + ecol); const f32x2 p0 = unpk_h2(w.x), p1 = unpk_h2(w.y); e_x = (f32x4){p0.x, p0.y, p1.x, p1.y}; }
    else e_x = *(const f32x4*)(E.xin_ctx + (size_t)(erow - ML) * DM + ecol);
    const f32x4 e_gs = E.gsn ? *(const f32x4*)(E.gsn + (size_t)2 * DM + ecol) : (f32x4){0.f, 0.f, 0.f, 0.f};
    f32x4 acc[2][4];
#pragma unroll
    for (int rb = 0; rb < 2; ++rb)
#pragma unroll
        for (int cb = 0; cb < 4; ++cb) acc[rb][cb] = (f32x4){0.f, 0.f, 0.f, 0.f};
    constexpr int CH = (KS >= 6) ? 3 : 2, NCH = (KS + CH - 1) / CH;
    bf16x8 fa[2][CH][2], fb[2][CH][4];
#define CTX_LOAD(c, buf) do { _Pragma("unroll") for (int q = 0; q < CH; ++q) if ((c) * CH + q < KS) { \
        _Pragma("unroll") for (int rb = 0; rb < 2; ++rb) fa[buf][q][rb] = *(const bf16x8*)(ap + (size_t)(16 * rb) * K + 32 * ((c) * CH + q)); \
        _Pragma("unroll") for (int cb = 0; cb < 4; ++cb) fb[buf][q][cb] = *(const bf16x8*)(bp + (size_t)(16 * cb) * K + 32 * ((c) * CH + q)); } } while (0)
    CTX_LOAD(0, 0);
#pragma unroll
    for (int c = 0; c < NCH; ++c) {
        __builtin_amdgcn_sched_barrier(0);
        if (c + 1 < NCH) CTX_LOAD(c + 1, (c + 1) & 1);
        __builtin_amdgcn_sched_barrier(0);
#pragma unroll
        for (int q = 0; q < CH; ++q) if (c * CH + q < KS) {
#pragma unroll
            for (int rb = 0; rb < 2; ++rb)
#pragma unroll
                for (int cb = 0; cb < 4; ++cb) acc[rb][cb] = __builtin_amdgcn_mfma_f32_16x16x32_bf16(fb[c & 1][q][cb], fa[c & 1][q][rb], acc[rb][cb], 0, 0, 0);
        }
    }
    __builtin_amdgcn_sched_barrier(0);
#undef CTX_LOAD
    LAS float* red = (LAS float*)lds;
#pragma unroll
    for (int rb = 0; rb < 2; ++rb)
#pragma unroll
        for (int cb = 0; cb < 4; ++cb) *(LAS f32x4*)(red + ((wave * 8 + rb * 4 + cb) * 64 + lane) * 4) = acc[rb][cb];
    __syncthreads();
    {
        const int r = tid >> 4, c4 = tid & 15, rb = r >> 4, j = r & 15, cb = c4 >> 2, q = c4 & 3, ln = q * 16 + j;
        f32x4 sum = (f32x4){0.f, 0.f, 0.f, 0.f};
#pragma unroll
        for (int w = 0; w < 8; ++w) sum += *(const LAS f32x4*)(red + ((w * 8 + rb * 4 + cb) * 64 + ln) * 4);
        const int row = erow, col = ecol;
        const f32x4 y = e_x + (e_gate * E.fac) * sum;
        { u32x2 w; w.x = pk_h2(y.x, y.y); w.y = pk_h2(y.z, y.w); *(u32x2*)(E.xout_bf + (size_t)row * DM + col) = w; }
        if (E.gsn) {
            const f32x4 av = y * e_gs;
            u32x2 w; w.x = cvt_pk_bf16(av.x, av.y); w.y = cvt_pk_bf16(av.z, av.w);
            *(u32x2*)(E.AH + (size_t)row * DM + col) = w;
            float ssq = (y.x * y.x + y.y * y.y) + (y.z * y.z + y.w * y.w);
            ssq += __shfl_xor(ssq, 1); ssq += __shfl_xor(ssq, 2); ssq += __shfl_xor(ssq, 4); ssq += __shfl_xor(ssq, 8);
            if (c4 == 0) E.SS[(size_t)row * 16 + ct] = ssq;
        }
    }
    __syncthreads();
}

#define XB_TMO      128
#define XB_XCNT(j)  (256  + 64 * (j))
#define XB_XSUB(j)  (1280 + 64 * (j))
#define XB_XGEN(j)  (2304 + 64 * (j))
#define XB_TOP      3328
#define XB_TOPGEN   3392
#define XCD_BAR_WORDS 3456
#define XB_SPIN_CAP (1u << 20)
__device__ __forceinline__ unsigned xb_ld(unsigned* p)              { return __hip_atomic_load(p, __ATOMIC_RELAXED, __HIP_MEMORY_SCOPE_AGENT); }
__device__ __forceinline__ unsigned xb_add(unsigned* p, unsigned v) { return __hip_atomic_fetch_add(p, v, __ATOMIC_RELAXED, __HIP_MEMORY_SCOPE_AGENT); }
__device__ __forceinline__ unsigned xb_xcc_id() { return (unsigned)__builtin_amdgcn_s_getreg((3 << 11) | 20) & 0xFu; }
#define XB_SPIN(cond, bar) do { unsigned _sp = 0; while (cond) { __builtin_amdgcn_s_sleep(1); \
    if ((++_sp & 255u) == 0u) { if (xb_ld(&(bar)[XB_TMO])) break; if (_sp > XB_SPIN_CAP) { atomicAdd(&(bar)[XB_TMO], 1u); break; } } } } while (0)
struct XcdBarrier { unsigned* bar; unsigned x; volatile LAS unsigned* st; };
__device__ __forceinline__ XcdBarrier xcd_barrier_post(unsigned* bar, volatile LAS unsigned* st) {
    XcdBarrier b; b.bar = bar; b.x = xb_xcc_id(); b.st = st;
    if (threadIdx.x == 0) (void)xb_add(&bar[XB_XCNT(b.x)], 1u);
    return b;
}
__device__ __forceinline__ void xcd_barrier_complete(unsigned* bar, unsigned x, unsigned& nloc, unsigned& nx) {
    const unsigned G = gridDim.x * gridDim.y * gridDim.z;
    unsigned sum, cnt, mine, sp = 0u;
    for (;;) {
        sum = 0u; cnt = 0u; mine = 0u;
#pragma unroll
        for (unsigned j = 0; j < 16; ++j) { const unsigned c = xb_ld(&bar[XB_XCNT(j)]); sum += c; cnt += (c > 0u) ? 1u : 0u; mine = (j == x) ? c : mine; }
        if (sum == G) break;
        __builtin_amdgcn_s_sleep(1);
        if ((++sp & 255u) == 0u) { if (xb_ld(&bar[XB_TMO])) break; if (sp > XB_SPIN_CAP) { atomicAdd(&bar[XB_TMO], 1u); break; } }
    }
    nloc = mine > 0u ? mine : 1u; nx = cnt > 0u ? cnt : 1u;
}
__device__ __forceinline__ void xcd_barrier(const XcdBarrier& b) {
    asm volatile("s_waitcnt vmcnt(0)" ::: "memory");
    __syncthreads();
    if (threadIdx.x == 0) {
        unsigned* bar = b.bar;
        __builtin_amdgcn_s_waitcnt(0);
        unsigned nloc = b.st[0], nx = b.st[1];
        if (nloc == 0u) { xcd_barrier_complete(bar, b.x, nloc, nx); b.st[0] = nloc; b.st[1] = nx; }
        const unsigned old = xb_add(&bar[XB_XSUB(b.x)], 1u);
        const unsigned gen = old / nloc;
        if (old + 1u == (gen + 1u) * nloc) {
            __builtin_amdgcn_fence(__ATOMIC_RELEASE, "agent");
            asm volatile("s_waitcnt vmcnt(0)" ::: "memory");
            const unsigned og = xb_add(&bar[XB_TOP], 1u);
            const unsigned tg = og / nx;
            if (og + 1u == (tg + 1u) * nx) xb_add(&bar[XB_TOPGEN], 1u);
            else XB_SPIN(xb_ld(&bar[XB_TOPGEN]) == tg, bar);
            __builtin_amdgcn_fence(__ATOMIC_ACQUIRE, "agent");
            xb_add(&bar[XB_XGEN(b.x)], 1u);
            asm volatile("s_waitcnt vmcnt(0)" ::: "memory");
        } else {
            XB_SPIN(xb_ld(&bar[XB_XGEN(b.x)]) == gen, bar);
            __builtin_amdgcn_fence(__ATOMIC_ACQUIRE, "agent");
            asm volatile("s_waitcnt vmcnt(0)" ::: "memory");
        }
    }
    __syncthreads();
}

struct Args { const float* in[19]; float* out; unsigned char* ws; int ph_lo, ph_hi; };
enum { I_X = 0, I_C, I_CTX, I_CCTX, I_WMOD, I_BMOD, I_NORMG, I_W13, I_W2, I_WINA, I_QKG, I_POOLW, I_POOLS, I_WOUTA, I_WINC, I_VNG, I_WSP, I_BSP, I_WOUTC };

__device__ const float INVF[16] = {1.0f, 0.5623413324356079f, 0.3162277638912201f, 0.17782793939113617f, 0.10000000149011612f, 0.05623413249850273f, 0.03162277489900589f, 0.017782794311642647f,
    0.009999999776482582f, 0.005623413249850273f, 0.003162277629598975f, 0.0017782794311642647f, 0.0010000000474974513f, 0.000562341301701963f, 0.0003162277571391314f, 0.00017782794020604342f};

__device__ __forceinline__ void transpose_item(const float* W, int N, bf16_t* WT, int Kd, int k0, int n0, int dst_row0, LAS float* scr, int lane) {
    float tv[32];
#pragma unroll
    for (int i = 0; i < 32; ++i) { const int kk = 2 * i + (lane >> 5); tv[i] = W[(size_t)(k0 + kk) * N + n0 + (lane & 31)]; }
#pragma unroll
    for (int i = 0; i < 32; ++i) { const int kk = 2 * i + (lane >> 5); scr[kk * 33 + (lane & 31)] = tv[i]; }
    asm volatile("s_waitcnt lgkmcnt(0)" ::: "memory");
    const int c = lane & 7;
#pragma unroll
    for (int j = 0; j < 4; ++j) { const int n = (lane >> 3) + 8 * j; const LAS float* s = scr + (8 * c) * 33 + n;
        u32x4 o; o.x = cvt_pk_bf16(s[0 * 33], s[1 * 33]); o.y = cvt_pk_bf16(s[2 * 33], s[3 * 33]); o.z = cvt_pk_bf16(s[4 * 33], s[5 * 33]); o.w = cvt_pk_bf16(s[6 * 33], s[7 * 33]);
        *(u32x4*)(WT + (size_t)(dst_row0 + n) * Kd + k0 + 8 * c) = o; }
    asm volatile("s_waitcnt lgkmcnt(0)" ::: "memory");
}

__device__ __forceinline__ void convert_w13(const Args& a, LAS unsigned char* lds, int mx, int first, int nblk) {
    if ((int)blockIdx.x < first) return;
    int tid_ = threadIdx.x; asm volatile("" : "+v"(tid_));
    const int tid = tid_, lane = tid & 63, wave = __builtin_amdgcn_readfirstlane(tid >> 6);
    LAS float* scr = (LAS float*)(lds + wave * 16384);
    const int gw = ((int)blockIdx.x - first) * 8 + wave, NGW = nblk * 8;
    for (int r = gw; r < 16 * 176; r += NGW) {
        const int kb = r / 176, nb = r % 176, n0 = nb * 32, half = n0 / DFF, idx = n0 % DFF;
        transpose_item(a.in[I_W13] + (size_t)mx * DM * NFF, NFF, (bf16_t*)(a.ws + WS_W13 + (size_t)mx * SZ_W13), DM, kb * 64, n0, (idx >> 7) * 256 + half * 128 + (idx & 127), scr, lane);
    }
}

__device__ __forceinline__ void phase_p0(const Args& a, LAS unsigned char* lds) {
    unsigned char* ws = a.ws;
    int tid_ = threadIdx.x; asm volatile("" : "+v"(tid_));
    const int tid = tid_, lane = tid & 63, wave = __builtin_amdgcn_readfirstlane(tid >> 6), G = gridDim.x;
    LAS float* sl = (LAS float*)(lds + LDS_SILU);
    for (int i = tid; i < 3 * DM; i += 512) { const float cv = (i < 2 * DM) ? a.in[I_C][i] : a.in[I_CCTX][i - 2 * DM]; sl[i] = cv / (1.0f + expf(-cv)); }
    {
        LAS float* scr = (LAS float*)(lds + wave * 16384);
        const int gw = blockIdx.x * 8 + wave, NGW = G * 8;
        constexpr int N13 = 16 * 176, N2 = 44 * 32, NINA = 16 * 40, NOUTA = 8 * 32, NINC = 16 * 64, NOUTC = 16 * 32;
        constexpr int T13 = 8 * N13, T2 = T13 + 8 * N2, TINA = T2 + 2 * NINA, TOUTA = TINA + 2 * NOUTA, TINC = TOUTA + 2 * NINC, TOUTC = TINC + 2 * NOUTC;
        for (int it0 = gw; it0 < TOUTC - 6 * N13; it0 += NGW) {
            const int it = it0 < 2 * N13 ? it0 : it0 + 6 * N13;
            if (it < T13) { const int mx = it / N13, r = it % N13, kb = r / 176, nb = r % 176, n0 = nb * 32, half = n0 / DFF, idx = n0 % DFF;
                if (mx >= 2) continue;
                transpose_item(a.in[I_W13] + (size_t)mx * DM * NFF, NFF, (bf16_t*)(ws + WS_W13 + mx * SZ_W13), DM, kb * 64, n0, (idx >> 7) * 256 + half * 128 + (idx & 127), scr, lane); }
            else if (it < T2) { const int q = it - T13, mx = q / N2, r = q % N2, kb = r / 32, nb = r % 32;
                transpose_item(a.in[I_W2] + (size_t)mx * DFF * DM, DM, (bf16_t*)(ws + WS_W2 + mx * SZ_W2), DFF, kb * 64, nb * 32, nb * 32, scr, lane); }
            else if (it < TINA) { const int q = it - T2, mx = q / NINA, r = q % NINA, kb = r / 40, nb = r % 40, n0 = nb * 32;
                int dst;
                if (n0 < 512) { const int head = n0 >> 6, d = n0 & 63; dst = (head >> 2) * 256 + (d >> 5) * 128 + (head & 3) * 32; }
                else if (n0 < 640) { const int head = (n0 - 512) >> 6, d = n0 & 63; dst = 512 + (d >> 5) * 128 + head * 32; }
                else if (n0 < 768) { const int head = (n0 - 640) >> 6, d = n0 & 63; dst = 512 + (d >> 5) * 128 + (2 + head) * 32; }
                else dst = n0;
                transpose_item(a.in[I_WINA] + (size_t)mx * DM * 1280, 1280, (bf16_t*)(ws + WS_WINA + mx * SZ_WINA), DM, kb * 64, n0, dst, scr, lane); }
            else if (it < TOUTA) { const int q = it - TINA, mx = q / NOUTA, r = q % NOUTA, kb = r / 32, nb = r % 32;
                transpose_item(a.in[I_WOUTA] + (size_t)mx * DM * DM, DM, (bf16_t*)(ws + WS_WOUTA + mx * SZ_WSQ), DM, kb * 64, nb * 32, nb * 32, scr, lane); }
            else if (it < TINC) { const int q = it - TOUTA, mx = q / NINC, r = q % NINC, kb = r / 64, nb = r % 64;
                transpose_item(a.in[I_WINC] + (size_t)mx * DM * 2048, 2048, (bf16_t*)(ws + WS_WINC + mx * SZ_WINC), DM, kb * 64, nb * 32, nb * 32, scr, lane); }
            else { const int q = it - TINC, mx = q / NOUTC, r = q % NOUTC, kb = r / 32, nb = r % 32;
                transpose_item(a.in[I_WOUTC] + (size_t)mx * DM * DM, DM, (bf16_t*)(ws + WS_WOUTC + mx * SZ_WSQ), DM, kb * 64, nb * 32, nb * 32, scr, lane); }
        }
    }
    __syncthreads();
    {
        LAS float* red = (LAS float*)lds;
        float* MOD = (float*)(ws + WS_MOD);
        for (int it = blockIdx.x; it < 4 * 144; it += G) {
            const int li = it / 144, j0 = (it % 144) * 64;
            const float* wp = a.in[I_WMOD] + (size_t)li * DM * NMOD + (size_t)(wave * 128) * NMOD + j0 + lane;
            float s0 = 0.f, s1 = 0.f, s2 = 0.f;
#pragma unroll 32
            for (int k = 0; k < 128; ++k) { const float w = wp[(size_t)k * NMOD]; const int kk = wave * 128 + k; s0 += sl[kk] * w; s1 += sl[DM + kk] * w; s2 += sl[2 * DM + kk] * w; }
            red[(wave * 3 + 0) * 64 + lane] = s0; red[(wave * 3 + 1) * 64 + lane] = s1; red[(wave * 3 + 2) * 64 + lane] = s2;
            __syncthreads();
            if (tid < 192) { const int m = tid >> 6; float s = a.in[I_BMOD][li * NMOD + j0 + lane];
#pragma unroll
                for (int w = 0; w < 8; ++w) s += red[(w * 3 + m) * 64 + lane];
                MOD[((size_t)li * 3 + m) * NMOD + j0 + lane] = s; }
            __syncthreads();
        }
    }
    for (int it = blockIdx.x; it < 2 * 4 * 16; it += G) {
        const int e = it >> 6, g = (it >> 4) & 3, nb = it & 15;
        const int n = nb * 64 + lane, k0 = wave * 16;
        const float* wo = a.in[I_WOUTA] + (size_t)e * DM * DM + (size_t)(512 + 128 * g) * DM + n;
        const float* ps = a.in[I_POOLS] + e * 512 + 128 * g;
        const float* pw = a.in[I_POOLW] + ((size_t)(e * 4 + g) * 128 + k0) * 128;
        float acc[16];
#pragma unroll
        for (int kk = 0; kk < 16; ++kk) acc[kk] = 0.f;
        for (int c = 0; c < 128; ++c) { const float wv = wo[(size_t)c * DM] * ps[c];
#pragma unroll
            for (int kk = 0; kk < 16; ++kk) acc[kk] += pw[kk * 128 + c] * wv; }
        bf16_t* dst = (bf16_t*)(ws + WS_WOUTA + e * SZ_WSQ) + (size_t)n * DM + 512 + 128 * g + k0;
        u32x4 w0, w1;
        w0.x = cvt_pk_bf16(acc[0], acc[1]); w0.y = cvt_pk_bf16(acc[2], acc[3]); w0.z = cvt_pk_bf16(acc[4], acc[5]); w0.w = cvt_pk_bf16(acc[6], acc[7]);
        w1.x = cvt_pk_bf16(acc[8], acc[9]); w1.y = cvt_pk_bf16(acc[10], acc[11]); w1.z = cvt_pk_bf16(acc[12], acc[13]); w1.w = cvt_pk_bf16(acc[14], acc[15]);
        *(u32x4*)dst = w0; *(u32x4*)(dst + 8) = w1;
    }
    {
        const int gt = blockIdx.x * 512 + tid, NGT = G * 512;
        bf16_t* wsp = (bf16_t*)(ws + WS_WSP);
        for (int i = gt; i < 2 * 8 * 128 * 128 / 2; i += NGT) { const f32x2 v = *(const f32x2*)(a.in[I_WSP] + 2 * (size_t)i); *(unsigned*)(wsp + 2 * (size_t)i) = cvt_pk_bf16(v.x, v.y); }
        float* rope = (float*)(ws + WS_ROPE);
        for (int i = gt; i < 128 * 16; i += NGT) {
            const int pos = i >> 4, f = i & 15;
            const float ang = (float)pos * INVF[f];
            double x = (double)ang; const double k = rint(x * 0.15915494309189535); x = fma(-k, 6.283185307179586, x);
            const double x2 = x * x; double ts = x, tc = 1.0, ss = x, cc = 1.0;
#pragma unroll
            for (int n = 1; n <= 14; ++n) { tc *= -x2 / (double)((2 * n - 1) * (2 * n)); ts *= -x2 / (double)((2 * n) * (2 * n + 1)); cc += tc; ss += ts; }
            rope[2 * i] = (float)cc; rope[2 * i + 1] = (float)ss;
        }
    }
}

__device__ __forceinline__ void bias_rows(const Args& a, int ls, int first, int nblk) {
    if ((int)blockIdx.x < first) return;
    unsigned char* ws = a.ws;
    int tid_ = threadIdx.x; asm volatile("" : "+v"(tid_));
    const int tid = tid_, lane = tid & 63, wave = __builtin_amdgcn_readfirstlane(tid >> 6);
    const int gw = ((int)blockIdx.x - first) * 8 + wave, NGW = nblk * 8;
    const float* MOD = (const float*)(ws + WS_MOD);
    {
        const int li = ls / 3, s = ls % 3;
        const bf16_t* Wt; int Nr;
        if (s == 1) { if (li & 1) { Wt = (const bf16_t*)(ws + WS_WINC + (li >> 1) * SZ_WINC); Nr = 2048; } else { Wt = (const bf16_t*)(ws + WS_WINA + (li >> 1) * SZ_WINA); Nr = 1280; } }
        else { Wt = (const bf16_t*)(ws + WS_W13 + (size_t)(li * 2 + (s >> 1)) * SZ_W13); Nr = NFF; }
        float sh[3][16];
#pragma unroll
        for (int mi = 0; mi < 3; ++mi)
#pragma unroll
            for (int j = 0; j < 2; ++j) { const float* sp = MOD + ((size_t)li * 3 + mi) * NMOD + (3 * s) * DM + 512 * j + 8 * lane;
                const f32x4 v0 = *(const f32x4*)sp, v1 = *(const f32x4*)(sp + 4);
                sh[mi][8 * j + 0] = v0.x; sh[mi][8 * j + 1] = v0.y; sh[mi][8 * j + 2] = v0.z; sh[mi][8 * j + 3] = v0.w; sh[mi][8 * j + 4] = v1.x; sh[mi][8 * j + 5] = v1.y; sh[mi][8 * j + 6] = v1.z; sh[mi][8 * j + 7] = v1.w; }
        float* BI = (float*)(ws + WS_BIAS) + (size_t)ls * 3 * NFF;
        for (int n4 = gw * 4; n4 < Nr; n4 += NGW * 4) {
            u32x4 w0[4], w1[4];
#pragma unroll
            for (int r = 0; r < 4; ++r) { w0[r] = *(const u32x4*)(Wt + (size_t)(n4 + r) * DM + 8 * lane); w1[r] = *(const u32x4*)(Wt + (size_t)(n4 + r) * DM + 512 + 8 * lane); }
            float dsum[4][3];
#pragma unroll
            for (int r = 0; r < 4; ++r) {
                float wv[16];
                wv[0] = bflo(w0[r].x); wv[1] = bfhi(w0[r].x); wv[2] = bflo(w0[r].y); wv[3] = bfhi(w0[r].y); wv[4] = bflo(w0[r].z); wv[5] = bfhi(w0[r].z); wv[6] = bflo(w0[r].w); wv[7] = bfhi(w0[r].w);
                wv[8] = bflo(w1[r].x); wv[9] = bfhi(w1[r].x); wv[10] = bflo(w1[r].y); wv[11] = bfhi(w1[r].y); wv[12] = bflo(w1[r].z); wv[13] = bfhi(w1[r].z); wv[14] = bflo(w1[r].w); wv[15] = bfhi(w1[r].w);
                float d0 = 0.f, d1 = 0.f, d2 = 0.f;
#pragma unroll
                for (int k = 0; k < 16; ++k) { d0 += sh[0][k] * wv[k]; d1 += sh[1][k] * wv[k]; d2 += sh[2][k] * wv[k]; }
                dsum[r][0] = wave_sum(d0); dsum[r][1] = wave_sum(d1); dsum[r][2] = wave_sum(d2);
            }
            if (lane < 12) { const int r = lane & 3, m = lane >> 2; float v = dsum[0][0];
#pragma unroll
                for (int rr = 0; rr < 4; ++rr)
#pragma unroll
                    for (int mm = 0; mm < 3; ++mm) if (r == rr && m == mm) v = dsum[rr][mm];
                BI[(size_t)m * NFF + n4 + r] = v; }
        }
    }
}

__device__ __forceinline__ void phase_p0b(const Args& a) {
    unsigned char* ws = a.ws;
    int tid_ = threadIdx.x; asm volatile("" : "+v"(tid_));
    const int tid = tid_, lane = tid & 63, wave = __builtin_amdgcn_readfirstlane(tid >> 6), G = gridDim.x;
    const int gw = blockIdx.x * 8 + wave, NGW = G * 8;
    const float* MOD = (const float*)(ws + WS_MOD);
    {
        float* GS = (float*)(ws + WS_GS);
        for (int i = blockIdx.x * 512 + tid; i < 12 * 3 * DM; i += G * 512) { const int col = i & 1023, mi = (i >> 10) % 3, ls = i / (3 * DM), li = ls / 3, s = ls % 3;
            GS[i] = a.in[I_NORMG][(size_t)ls * DM + col] * (1.0f + MOD[((size_t)li * 3 + mi) * NMOD + (3 * s + 1) * DM + col]); }
    }
    for (int ls = 0; ls < 12; ++ls) if (ls < 3 || ls % 3 == 1) bias_rows(a, ls, 0, G);
    {
        bf16_t* AH = (bf16_t*)(ws + WS_AH); float* SS = (float*)(ws + WS_SS);
        for (int row = gw; row < MT; row += NGW) {
            const int mi = row < SEQ ? 0 : (row < ML ? 1 : 2);
            const float* xr = (row < ML) ? a.in[I_X] + (size_t)row * DM : a.in[I_CTX] + (size_t)(row - ML) * DM;
            const float* gp = a.in[I_NORMG];
            const float* scp = MOD + (size_t)mi * NMOD + DM;
            float ssq = 0.f;
#pragma unroll
            for (int j = 0; j < 4; ++j) { const int col = 256 * j + 4 * lane;
                const f32x4 v = *(const f32x4*)(xr + col), g = *(const f32x4*)(gp + col), sc = *(const f32x4*)(scp + col);
                ssq += (v.x * v.x + v.y * v.y) + (v.z * v.z + v.w * v.w);
                const f32x4 o = v * g * (sc + 1.0f);
                u32x2 w; w.x = cvt_pk_bf16(o.x, o.y); w.y = cvt_pk_bf16(o.z, o.w);
                *(u32x2*)(AH + (size_t)row * DM + col) = w; }
            ssq = wave_sum(ssq);
            if (lane < 16) SS[(size_t)row * 16 + lane] = (lane == 0) ? ssq : 0.f;
        }
    }
}

template <int HW> __device__ __forceinline__ void pool_rows(const unsigned* __restrict__ Pc, bf16_t* __restrict__ AOc, int t0, int n) {
    unsigned w[32 + 2 * HW];
#pragma unroll
    for (int j = 0; j < 32 + 2 * HW; ++j) { const int t = t0 - HW + j; w[j] = (t >= 0 && t < n) ? Pc[(size_t)t * 256] : 0u; }
    float s0 = 0.f, s1 = 0.f;
#pragma unroll
    for (int j = 0; j < 2 * HW; ++j) { s0 += bflo(w[j]); s1 += bfhi(w[j]); }
#pragma unroll
    for (int i = 0; i < 32; ++i) {
        const int t = t0 + i, lo = max(t - HW, 0), hi_ = min(t + HW, n);
        const float inv = 1.0f / (float)(hi_ - lo);
        *(unsigned*)(AOc + (size_t)t * DM) = cvt_pk_bf16(s0 * inv - bflo(w[i + HW]), s1 * inv - bfhi(w[i + HW]));
        if (i < 31) { s0 += bflo(w[i + 2 * HW]) - bflo(w[i]); s1 += bfhi(w[i + 2 * HW]) - bfhi(w[i]); }
    }
}
__device__ __forceinline__ void pool_unit(const bf16_t* P, bf16_t* AO, int unit) {
    int tid_ = threadIdx.x; asm volatile("" : "+v"(tid_));
    const int tid = tid_, half = tid >> 8, cp = tid & 255, g = __builtin_amdgcn_readfirstlane(cp >> 6);
    const int row0 = unit * 64 + half * 32;
    int base, n;
    if (row0 < ML) { base = row0 & ~(SEQ - 1); n = SEQ; } else { base = ML + ((row0 - ML) & ~(CTXL - 1)); n = CTXL; }
    const int t0 = row0 - base;
    const unsigned* Pc = (const unsigned*)(P + (size_t)base * 512) + cp;
    bf16_t* AOc = AO + (size_t)base * DM + 512 + 2 * cp;
    if (g == 0) pool_rows<1>(Pc, AOc, t0, n); else if (g == 1) pool_rows<2>(Pc, AOc, t0, n); else if (g == 2) pool_rows<4>(Pc, AOc, t0, n); else pool_rows<8>(Pc, AOc, t0, n);
}

__device__ __forceinline__ void spatial_unit(const Args& a, LAS unsigned char* lds, int o, int ch, int g) {
    unsigned char* ws = a.ws;
    int tid_ = threadIdx.x; asm volatile("" : "+v"(tid_));
    const int tid = tid_, lane = tid & 63, wave = __builtin_amdgcn_readfirstlane(tid >> 6);
    const bf16_t* U = (const bf16_t*)(ws + WS_H); const bf16_t* V = U + (size_t)MT * DM; const float* VSS = (const float*)(ws + WS_VSS);
    bf16_t* Gout = (bf16_t*)(ws + WS_AO);
    LAS bf16_t* VnT = (LAS bf16_t*)lds;
    LAS float* rst = (LAS float*)(lds + 128 * 136 * 2);
    const int r0 = ch * 128;
    if (tid < 128) { const float* p = VSS + (size_t)(r0 + tid) * 16; const f32x4 v0 = *(const f32x4*)p, v1 = *(const f32x4*)(p + 4), v2 = *(const f32x4*)(p + 8), v3 = *(const f32x4*)(p + 12);
        const float s = ((v0.x + v0.y) + (v0.z + v0.w)) + ((v1.x + v1.y) + (v1.z + v1.w)) + ((v2.x + v2.y) + (v2.z + v2.w)) + ((v3.x + v3.y) + (v3.z + v3.w));
        rst[tid] = 1.0f / sqrtf(s * (1.0f / 1024.0f) + EPS); }
    __syncthreads();
    const float* vg = a.in[I_VNG] + (size_t)o * DM + g * 128;
#pragma unroll
    for (int it = 0; it < 4; ++it) {
        const int idx = tid + 512 * it, q = idx >> 4, c8 = (idx & 15) * 8;
        const u32x4 w = *(const u32x4*)(V + (size_t)(r0 + q) * DM + g * 128 + c8);
        const f32x4 g0 = *(const f32x4*)(vg + c8), g1 = *(const f32x4*)(vg + c8 + 4);
        const float rs = rst[q];
        const float v[8] = {bflo(w.x) * rs * g0.x, bfhi(w.x) * rs * g0.y, bflo(w.y) * rs * g0.z, bfhi(w.y) * rs * g0.w, bflo(w.z) * rs * g1.x, bfhi(w.z) * rs * g1.y, bflo(w.w) * rs * g1.z, bfhi(w.w) * rs * g1.w};
#pragma unroll
        for (int e = 0; e < 8; e += 2) { const unsigned pk = cvt_pk_bf16(v[e], v[e + 1]); VnT[(c8 + e) * 136 + q] = (bf16_t)(pk & 0xffffu); VnT[(c8 + e + 1) * 136 + q] = (bf16_t)(pk >> 16); }
    }
    __syncthreads();
    const int pl = lane & 15, kq = lane >> 4, p = wave * 16 + pl;
    const bf16_t* wsp = (const bf16_t*)(ws + WS_WSP) + ((size_t)(o * 8 + g) * 128 + p) * 128;
    bf16x8 bw[4];
#pragma unroll
    for (int ks = 0; ks < 4; ++ks) bw[ks] = *(const bf16x8*)(wsp + 32 * ks + 8 * kq);
    f32x4 acc[8];
#pragma unroll
    for (int nb = 0; nb < 8; ++nb) { acc[nb] = (f32x4){0.f, 0.f, 0.f, 0.f};
#pragma unroll
        for (int ks = 0; ks < 4; ++ks) { const bf16x8 av = *(const LAS bf16x8*)(VnT + (16 * nb + pl) * 136 + 32 * ks + 8 * kq);
            acc[nb] = __builtin_amdgcn_mfma_f32_16x16x32_bf16(av, bw[ks], acc[nb], 0, 0, 0); } }
    const float bsp = a.in[I_BSP][(size_t)(o * 8 + g) * 128 + p];
    const size_t ro = (size_t)(r0 + p) * DM + g * 128 + 4 * kq;
#pragma unroll
    for (int nb = 0; nb < 8; ++nb) { const u32x2 uw = *(const u32x2*)(U + ro + 16 * nb);
        u32x2 w; w.x = cvt_pk_bf16(bflo(uw.x) * (acc[nb].x + bsp), bfhi(uw.x) * (acc[nb].y + bsp)); w.y = cvt_pk_bf16(bflo(uw.y) * (acc[nb].z + bsp), bfhi(uw.y) * (acc[nb].w + bsp));
        *(u32x2*)(Gout + ro + 16 * nb) = w; }
    __syncthreads();
}

__global__ void __launch_bounds__(512, 2) fwd_megakernel(Args a) {
    extern __shared__ __attribute__((aligned(16))) unsigned char lds_raw[];
    LAS unsigned char* lds = (LAS unsigned char*)lds_raw;
    unsigned char* ws = a.ws;
    const int G = gridDim.x, lo = a.ph_lo, hi = a.ph_hi;
    int ph = 0;
    volatile LAS unsigned* misc = (volatile LAS unsigned*)(lds + LDS_MISC);
    XcdBarrier bar; bar.bar = (unsigned*)(ws + WS_CTL); bar.x = 0; bar.st = misc;
    if (hi - lo > 1) {
        if (threadIdx.x == 0) { misc[0] = 0u; misc[1] = 0u; }
        __syncthreads();
        bar = xcd_barrier_post((unsigned*)(ws + WS_CTL), misc);
    }
#define PHASE_BEGIN if (ph >= lo && ph < hi) {
#define PHASE_END   if (ph + 1 < hi) { if (lo < 0) cg::this_grid().sync(); else xcd_barrier(bar); } } ++ph;

    PHASE_BEGIN phase_p0(a, lds); PHASE_END
    PHASE_BEGIN phase_p0b(a); PHASE_END

    const float* MOD = (const float*)(ws + WS_MOD);
    bf16_t* X = (bf16_t*)(ws + WS_X); bf16_t* AH = (bf16_t*)(ws + WS_AH); float* SS = (float*)(ws + WS_SS); bf16_t* H = (bf16_t*)(ws + WS_H);
    bf16_t* AO = (bf16_t*)(ws + WS_AO);
    for (int L = 0; L < 4; ++L) {
        const bool even = (L & 1) == 0;
        const int Mfull = (L <= 2) ? MT : ML;
        const int Mlate = (L <= 1) ? MT : ML;
        const float* BIAS = (const float*)(ws + WS_BIAS) + (size_t)(L * 3) * 3 * NFF;
        const float* GS = (const float*)(ws + WS_GS) + (size_t)(L * 3) * 3 * DM;
        const float* MODL = MOD + (size_t)L * 3 * NMOD;
        PHASE_BEGIN {
            pg8::Gemm g{AH, (const bf16_t*)(ws + WS_W13 + (size_t)(L * 2) * SZ_W13), Mfull, NFF, DM}; pg8::StaticOrder S; S.init(Mfull, NFF, G, (int)blockIdx.x);
            pg8::EpiSwiGLU E{H, SS, BIAS};
            pg8::gemm_phase<pg8::EpiSwiGLU, pg8::StaticOrder, true, true>(lds, g, S, E);
            { const int rem = S.nwg % G, first = rem ? rem : 0, nidle = G - first;
              if (L >= 1) bias_rows(a, L * 3 + 2, first, nidle); }
        } PHASE_END
        PHASE_BEGIN {
            const bf16_t* Wt = (const bf16_t*)(ws + WS_W2 + (size_t)(L * 2) * SZ_W2);
            pg8::Gemm g{H, Wt, ML, DM, DFF}; pg8::StaticOrder S; S.init(ML, DM, G, (int)blockIdx.x);
            pg8::EpiResid E{a.in[I_X], a.in[I_CTX], L == 0 ? nullptr : X, X, nullptr, MODL + 2 * DM, GS + 3 * DM, AH, SS, 0.5f, 0};
            if (Mfull == MT) for (int t = blockIdx.x; t < 256; t += G) ctx_gemm_resid<11>(lds, H, Wt, E, t);
            pg8::gemm_phase<pg8::EpiResid, pg8::StaticOrder, true, true>(lds, g, S, E);
        } PHASE_END
        PHASE_BEGIN {
            if (even) {
                pg8::Gemm g{AH, (const bf16_t*)(ws + WS_WINA + (size_t)(L >> 1) * SZ_WINA), Mfull, 1280, DM}; pg8::StaticOrder S; S.init(Mfull, 1280, G, (int)blockIdx.x);
                pg8::EpiInA E{SS, BIAS + 3 * NFF, a.in[I_QKG] + (L >> 1) * 128, (const float*)(ws + WS_ROPE), (bf16_t*)(ws + WS_Q), (bf16_t*)(ws + WS_KB), (bf16_t*)(ws + WS_VB), (bf16_t*)(ws + WS_P)};
                pg8::gemm_phase<pg8::EpiInA, pg8::StaticOrder, true, true>(lds, g, S, E);
                { const int rem = S.nwg % G, first = rem ? rem : 0; if (L < 3) convert_w13(a, lds, (L + 1) * 2, first, G - first); }
            } else {
                pg8::Gemm g{AH, (const bf16_t*)(ws + WS_WINC + (size_t)(L >> 1) * SZ_WINC), Mlate, 2048, DM}; pg8::StaticOrder S; S.init(Mlate, 2048, G, (int)blockIdx.x);
                pg8::EpiInC E{SS, BIAS + 3 * NFF, H, H + (size_t)MT * DM, (float*)(ws + WS_VSS)};
                pg8::gemm_phase<pg8::EpiInC, pg8::StaticOrder, true, true>(lds, g, S, E);
                { const int rem = S.nwg % G, first = rem ? rem : 0; if (L < 3) convert_w13(a, lds, (L + 1) * 2, first, G - first); }
            }
        } PHASE_END
        PHASE_BEGIN {
            if (even) {
                const attn_body::bf16* Qb = (const attn_body::bf16*)(ws + WS_Q); const attn_body::bf16* Kb = (const attn_body::bf16*)(ws + WS_KB); const attn_body::bf16* Vb = (const attn_body::bf16*)(ws + WS_VB);
                attn_body::bf16* Ob = (attn_body::bf16*)AO;
                const int bid = blockIdx.x;
                for (int r = 0; ; ++r) {
                    int uidx;
                    if (G == 256) { if (r >= 2) break; const int x = bid & 7; uidx = (x >> 1) * 128 + (x & 1) * 64 + (bid >> 3) * 2 + r; }
                    else { uidx = bid + r * G; if (uidx >= 512) break; }
                    const int combo = uidx >> 7, idx = uidx & 127, b = combo >> 1, kvh = combo & 1, h = kvh * 4 + (idx >> 5), qb = idx & 31;
                    const size_t qrow = (size_t)b * SEQ + qb * 256;
                    attn_body::attn_unit<8>(Qb + qrow * 512 + h * 64, Kb + (size_t)(b * 2 + kvh) * KVROWS * 64, Vb + (size_t)(b * 2 + kvh) * KVROWS * 64, KVROWS / 64, Ob + qrow * DM + h * 64, (char*)lds_raw);
                }
                const int nctx = (L == 0) ? 16 : 0, npool = (L == 0) ? MT / 64 : ML / 64;
                for (int it = blockIdx.x; it < nctx + npool; it += G) {
                    if (it < nctx) { const int b = it >> 3, h = it & 7, kvh = h >> 2; const size_t qrow = (size_t)ML + b * CTXL;
                        attn_body::attn_unit<8>(Qb + qrow * 512 + h * 64, Kb + (size_t)(b * 2 + kvh) * KVROWS * 64, Vb + (size_t)(b * 2 + kvh) * KVROWS * 64, CTXL / 64, Ob + qrow * DM + h * 64, (char*)lds_raw); }
                    else pool_unit((const bf16_t*)(ws + WS_P), AO, it - nctx);
                }
            } else {
                const int nch = Mlate / 128;
                for (int it = blockIdx.x; it < nch * 8; it += G) spatial_unit(a, lds, L >> 1, it >> 3, it & 7);
            }
        } PHASE_END
        PHASE_BEGIN {
            const bf16_t* Wt = even ? (const bf16_t*)(ws + WS_WOUTA + (size_t)(L >> 1) * SZ_WSQ) : (const bf16_t*)(ws + WS_WOUTC + (size_t)(L >> 1) * SZ_WSQ);
            pg8::Gemm g{AO, Wt, ML, DM, DM}; pg8::StaticOrder S; S.init(ML, DM, G, (int)blockIdx.x);
            pg8::EpiResid E{a.in[I_X], a.in[I_CTX], X, X, nullptr, MODL + 5 * DM, GS + 2 * 3 * DM, AH, SS, 1.0f, 0};
            if (Mlate == MT) for (int t = blockIdx.x; t < 256; t += G) ctx_gemm_resid<4>(lds, AO, Wt, E, t);
            pg8::gemm_phase<pg8::EpiResid, pg8::StaticOrder, true, true>(lds, g, S, E);
        } PHASE_END
        PHASE_BEGIN {
            pg8::Gemm g{AH, (const bf16_t*)(ws + WS_W13 + (size_t)(L * 2 + 1) * SZ_W13), Mlate, NFF, DM}; pg8::StaticOrder S; S.init(Mlate, NFF, G, (int)blockIdx.x);
            pg8::EpiSwiGLU E{H, SS, BIAS + 2 * 3 * NFF};
            pg8::gemm_phase<pg8::EpiSwiGLU, pg8::StaticOrder, true, true>(lds, g, S, E);
            { const int rem = S.nwg % G, first = rem ? rem : 0, nidle = G - first;
              if (L < 3) { convert_w13(a, lds, (L + 1) * 2 + 1, first, nidle); bias_rows(a, (L + 1) * 3, first, nidle); } }
        } PHASE_END
        PHASE_BEGIN {
            const bf16_t* Wt = (const bf16_t*)(ws + WS_W2 + (size_t)(L * 2 + 1) * SZ_W2);
            pg8::Gemm g{H, Wt, ML, DM, DFF}; pg8::StaticOrder S; S.init(ML, DM, G, (int)blockIdx.x);
            pg8::EpiResid E{a.in[I_X], a.in[I_CTX], X, X, L == 3 ? a.out : nullptr, MODL + 8 * DM, L == 3 ? nullptr : GS + (size_t)3 * 3 * DM, AH, SS, 0.5f, 0};
            if (Mlate == MT) for (int t = blockIdx.x; t < 256; t += G) ctx_gemm_resid<11>(lds, H, Wt, E, t);
            pg8::gemm_phase<pg8::EpiResid, pg8::StaticOrder, true, true>(lds, g, S, E);
        } PHASE_END
    }
#undef PHASE_BEGIN
#undef PHASE_END
}

constexpr int N_PHASES = 2 + 4 * 7;

extern "C" void kernel_launch(void* const* d_in, const int* in_sizes, int n_in, void* d_out, int out_size, void* d_ws, size_t ws_size, hipStream_t stream) {
    static int grid = 0;
    if (grid == 0) {
        if (n_in != 19 || ws_size < WS_END) { fprintf(stderr, "kernel_launch: unexpected inputs (n_in %d, ws %zu, need %zu)\n", n_in, ws_size, (size_t)WS_END); grid = -1; return; }
        int dev = 0, cus = 0, per_cu = 0;
        hipGetDevice(&dev);
        hipDeviceGetAttribute(&cus, hipDeviceAttributeMultiprocessorCount, dev);
        if (hipFuncSetAttribute((const void*)fwd_megakernel, hipFuncAttributeMaxDynamicSharedMemorySize, LDS_BYTES) != hipSuccess) { fprintf(stderr, "kernel_launch: hipFuncSetAttribute failed\n"); grid = -1; return; }
        if (hipOccupancyMaxActiveBlocksPerMultiprocessor(&per_cu, (const void*)fwd_megakernel, 512, LDS_BYTES) != hipSuccess || per_cu < 1) { fprintf(stderr, "kernel_launch: occupancy query says %d\n", per_cu); per_cu = 1; }
        (void)hipGetLastError();
        grid = cus * (per_cu > 1 ? 1 : per_cu);
        if (grid <= 0) grid = 256;
    }
    if (grid < 0) return;
    Args a{};
    for (int i = 0; i < 19; ++i) a.in[i] = (const float*)d_in[i];
    a.out = (float*)d_out; a.ws = (unsigned char*)d_ws;
#if MK_PER_PHASE
    for (int p = 0; p < N_PHASES; ++p) { a.ph_lo = p; a.ph_hi = p + 1; hipLaunchKernelGGL(fwd_megakernel, dim3(grid), dim3(512), LDS_BYTES, stream, a); }
#else
    a.ph_lo = 0; a.ph_hi = N_PHASES;
    if (hipMemsetAsync((char*)d_ws + WS_CTL, 0, CTL_BYTES, stream) != hipSuccess) { fprintf(stderr, "kernel_launch: memset of the barrier words failed\n"); return; }
    void* args[] = {&a};
    hipError_t e = hipLaunchCooperativeKernel((const void*)fwd_megakernel, dim3(grid), dim3(512), args, LDS_BYTES, stream);
    if (e != hipSuccess) fprintf(stderr, "cooperative launch failed: %s (grid %d)\n", hipGetErrorString(e), grid);
#endif
}
```

```cpp
#include <hip/hip_runtime.h>
#include <hip/hip_cooperative_groups.h>
#include <hip/hip_bf16.h>
#include <cstdio>
#include <cstdint>
namespace cg = cooperative_groups;

#ifndef RESID_NBUF
#define RESID_NBUF 3
#endif
#ifndef MK_PER_PHASE
#define MK_PER_PHASE 0
#endif

#define LAS __attribute__((address_space(3)))
typedef unsigned short bf16_t;
typedef short bf16x8 __attribute__((ext_vector_type(8)));
typedef float f32x4 __attribute__((ext_vector_type(4)));
typedef float f32x2 __attribute__((ext_vector_type(2)));
typedef unsigned u32x4 __attribute__((ext_vector_type(4)));
typedef unsigned u32x2 __attribute__((ext_vector_type(2)));

constexpr int DM = 1024, SEQ = 8192, CTXL = 256, ML = 16384, MC = 512, MT = ML + MC, DFF = 2816, NFF = 5632;
constexpr int KVROWS = CTXL + SEQ;
constexpr int NMOD = 9 * DM;
constexpr float EPS = 1e-6f;
constexpr float QSCALE = 0.125f * 1.4426950408889634f;

constexpr size_t SZ_W13 = (size_t)NFF * DM * 2, SZ_W2 = (size_t)DM * DFF * 2, SZ_WINA = (size_t)1280 * DM * 2, SZ_WSQ = (size_t)DM * DM * 2, SZ_WINC = (size_t)2048 * DM * 2, SZ_WSP = (size_t)8 * 128 * 128 * 2;
constexpr size_t WS_W13 = 0;
constexpr size_t WS_W2 = WS_W13 + 8 * SZ_W13;
constexpr size_t WS_WINA = WS_W2 + 8 * SZ_W2;
constexpr size_t WS_WOUTA = WS_WINA + 2 * SZ_WINA;
constexpr size_t WS_WINC = WS_WOUTA + 2 * SZ_WSQ;
constexpr size_t WS_WOUTC = WS_WINC + 2 * SZ_WINC;
constexpr size_t WS_WSP = WS_WOUTC + 2 * SZ_WSQ;
constexpr size_t WS_MOD = WS_WSP + 2 * SZ_WSP;
constexpr size_t WS_BIAS = WS_MOD + (size_t)4 * 3 * NMOD * 4;
constexpr size_t WS_GS = WS_BIAS + (size_t)12 * 3 * NFF * 4;
constexpr size_t WS_ROPE = WS_GS + (size_t)12 * 3 * DM * 4;
constexpr size_t WS_SS = WS_ROPE + (size_t)128 * 16 * 2 * 4;
constexpr size_t WS_VSS = WS_SS + (size_t)MT * 16 * 4;
constexpr size_t WS_X = WS_VSS + (size_t)MT * 16 * 4;
constexpr size_t WS_AH = WS_X + (size_t)MT * DM * 4;
constexpr size_t WS_H = WS_AH + (size_t)MT * DM * 2;
constexpr size_t WS_Q = WS_H + (size_t)MT * DFF * 2;
constexpr size_t WS_KB = WS_Q + (size_t)MT * 512 * 2;
constexpr size_t WS_VB = WS_KB + (size_t)2 * KVROWS * 128 * 2;
constexpr size_t WS_P = WS_VB + (size_t)2 * KVROWS * 128 * 2;
constexpr size_t WS_AO = WS_P + (size_t)MT * 512 * 2;
constexpr size_t WS_CTL = WS_AO + (size_t)MT * DM * 2;
constexpr size_t CTL_BYTES = 16384;
constexpr size_t WS_END = WS_CTL + CTL_BYTES;
static_assert(WS_W2 % 256 == 0 && WS_MOD % 256 == 0 && WS_BIAS % 256 == 0 && WS_SS % 256 == 0 && WS_X % 256 == 0 && WS_H % 256 == 0 && WS_KB % 256 == 0 && WS_AO % 256 == 0, "ws alignment");

constexpr int LDS_BYTES = 147456;
constexpr int LDS_SILU = 131072;
constexpr int LDS_MISC = LDS_BYTES - 256;

__device__ __forceinline__ unsigned cvt_pk_bf16(float lo, float hi) { unsigned r; asm volatile("v_cvt_pk_bf16_f32 %0, %1, %2" : "=v"(r) : "v"(lo), "v"(hi)); return r; }
__device__ __forceinline__ float bf2f(unsigned short h) { return __uint_as_float((unsigned)h << 16); }
__device__ __forceinline__ float bflo(unsigned w) { return __uint_as_float(w << 16); }
__device__ __forceinline__ float bfhi(unsigned w) { return __uint_as_float(w & 0xffff0000u); }
typedef _Float16 h16x2 __attribute__((ext_vector_type(2)));
__device__ __forceinline__ unsigned pk_h2(float lo, float hi) { f32x2 v; v.x = __builtin_fminf(__builtin_fmaxf(lo, -65000.f), 65000.f); v.y = __builtin_fminf(__builtin_fmaxf(hi, -65000.f), 65000.f);
    const h16x2 h = __builtin_convertvector(v, h16x2); return __builtin_bit_cast(unsigned, h); }
__device__ __forceinline__ f32x2 unpk_h2(unsigned w) { const h16x2 h = __builtin_bit_cast(h16x2, w); return __builtin_convertvector(h, f32x2); }
__device__ __forceinline__ float fast_rcp(float x) { return __builtin_amdgcn_rcpf(x); }
__device__ __forceinline__ float silu_f(float a) { return a * fast_rcp(1.0f + __builtin_amdgcn_exp2f(-1.4426950408889634f * a)); }
__device__ __forceinline__ float gelu_tanh_f(float x) { const float t = x * (-2.3022081986f + -0.1029432396f * x * x); return x * fast_rcp(1.0f + __builtin_amdgcn_exp2f(t)); }
__device__ __forceinline__ float wave_sum(float v) {
#pragma unroll
    for (int o = 1; o < 64; o <<= 1) v += __shfl_xor(v, o);
    return v;
}
__device__ __forceinline__ int mod_index_of_tile(int pm) { return pm < 32 ? 0 : (pm < 64 ? 1 : 2); }
__device__ __forceinline__ float row_rstd16(const float* SS, int row, int fq) {
    const f32x4 v = *(const f32x4*)(SS + (size_t)row * 16 + 4 * fq);
    float s = (v.x + v.y) + (v.z + v.w);
    s += __shfl_xor(s, 16); s += __shfl_xor(s, 32);
    return 1.0f / sqrtf(s * (1.0f / 1024.0f) + EPS);
}

__device__ __forceinline__ void row_rstd16x8(const float* SS, int row0, int fq, float (&rs)[2][4]) {
    f32x4 v[2][4];
#pragma unroll
    for (int ai = 0; ai < 2; ++ai)
#pragma unroll
        for (int m = 0; m < 4; ++m) v[ai][m] = *(const f32x4*)(SS + (size_t)(row0 + ai * 128 + m * 16) * 16 + 4 * fq);
#pragma unroll
    for (int ai = 0; ai < 2; ++ai)
#pragma unroll
        for (int m = 0; m < 4; ++m) { float t = (v[ai][m].x + v[ai][m].y) + (v[ai][m].z + v[ai][m].w); t += __shfl_xor(t, 16); t += __shfl_xor(t, 32); rs[ai][m] = 1.0f / sqrtf(t * (1.0f / 1024.0f) + EPS); }
}

namespace pg8 {
constexpr int BM = 256, BK = 64, HALF = 128, HTB = HALF * BK * 2, STAGE_BYTES = 8 * HTB, NXCD = 8, WGM = 8;
__host__ __device__ __forceinline__ int lds_byte(int r, int c) { const int st = (r >> 4) * 2 + (c >> 5), rr = r & 15, cc = c & 31, ob = rr * 64 + cc * 2; return st * 1024 + (ob ^ (((ob >> 9) & 1) << 5)); }
__host__ __device__ __forceinline__ void stage_rc(int b, int& R, int& C) { const int st = b / 1024, sb = b % 1024, swz = sb ^ (((sb >> 9) & 1) << 5); R = (st >> 1) * 16 + swz / 64; C = (st & 1) * 32 + (swz % 64) / 2; }
__host__ __device__ __forceinline__ int perm32(int rho) { const int n = rho >> 4, i = rho & 15; return 8 * (i >> 2) + 4 * n + (i & 3); }
struct Unit { int pm, pn; };
struct Gemm { const bf16_t* A; const bf16_t* Bt; int M, N, K; };
struct StaticOrder {
    int nM, nN, nwg, G, c;
    __host__ __device__ void init(int M, int N, int G_, int c_) { nM = M / BM; nN = N / BM; nwg = nM * nN; G = G_; c = c_; }
    __host__ __device__ bool next(int i, Unit& u) const {
        const long L = (long)i * G + c; if (L >= nwg) return false;
        int wgid = (int)L; { const int q = nwg / NXCD, r = nwg % NXCD, xcd = wgid % NXCD, off = wgid / NXCD; wgid = (xcd < r ? xcd * (q + 1) : r * (q + 1) + (xcd - r) * q) + off; }
        const int nig = WGM * nN, gid = wgid / nig, fm = gid * WGM, gsz = (nM - fm) < WGM ? (nM - fm) : WGM;
        u.pm = fm + ((wgid % nig) % gsz); u.pn = (wgid % nig) / gsz; return true;
    }
    __device__ __forceinline__ void a_ready(const Unit&) const {}
    __device__ __forceinline__ void done(const Unit&) const {}
};

template <class Epi, class Sched, bool ALIGN_EPI = false, bool SP2 = false>
__device__ __forceinline__ void gemm_phase(LAS unsigned char* lds, const Gemm g, const Sched& S, const Epi& E) {
    int tid_ = threadIdx.x; asm volatile("" : "+v"(tid_));
    const int tid = tid_, wid = __builtin_amdgcn_readfirstlane(tid >> 6), lane = tid & 63, wr = wid >> 2, wc = wid & 3, fr = lane & 15, fq = lane >> 4;
    const int K = g.K, nt = K / BK;
    unsigned voffA[2], voffB[2];
#pragma unroll
    for (int i = 0; i < 2; ++i) { int R, C; stage_rc(tid * 16 + i * 8192, R, C); const int Rb = Epi::PERM ? ((R & ~31) + perm32(R & 31)) : R;
        voffA[i] = (unsigned)(R * K + C) * 2u; voffB[i] = (unsigned)(Rb * K + C) * 2u; }
    const size_t kstep = (size_t)(BK * 2);
    const size_t hstep = (size_t)HALF * K * 2;
    const size_t tstep = 2 * hstep;
    const unsigned ldsw = (unsigned)wid * 1024u;
    const int aoff = lds_byte(wr * 64 + fr, fq * 8), boff = lds_byte(wc * 32 + fr, fq * 8);
#define PG8_SA(b, h) (((b) * 2 + (h)) * HTB)
#define PG8_SB(b, h) ((4 + (b) * 2 + (h)) * HTB)
#define PG8_STAGE(bufoff, gbase, voff) do { _Pragma("unroll") for (int _i = 0; _i < 2; ++_i) \
        __builtin_amdgcn_global_load_lds((const unsigned*)((const char*)(gbase) + (voff)[_i]), (LAS unsigned*)(lds + (bufoff) + ldsw + _i * 8192), 16, 0, 0); } while (0)
#define PG8_LDA(dst, b, h) do { _Pragma("unroll") for (int m = 0; m < 4; ++m) _Pragma("unroll") for (int k = 0; k < 2; ++k) dst[m][k] = *(const LAS bf16x8*)(lds + PG8_SA(b, h) + aoff + m * 2048 + k * 1024); } while (0)
#define PG8_LDB(dst, b, h) do { _Pragma("unroll") for (int n = 0; n < 2; ++n) _Pragma("unroll") for (int k = 0; k < 2; ++k) dst[n][k] = *(const LAS bf16x8*)(lds + PG8_SB(b, h) + boff + n * 2048 + k * 1024); } while (0)
#define PG8_MMA(ai, bj, At, Bt) do { __builtin_amdgcn_s_setprio(1); _Pragma("unroll") for (int m = 0; m < 4; ++m) _Pragma("unroll") for (int n = 0; n < 2; ++n) _Pragma("unroll") for (int k = 0; k < 2; ++k) \
        acc[ai][bj][m][n] = __builtin_amdgcn_mfma_f32_16x16x32_bf16(Bt[n][k], At[m][k], acc[ai][bj][m][n], 0, 0, 0); __builtin_amdgcn_s_setprio(0); } while (0)
#define PG8_WAIT_V(n) asm volatile("s_waitcnt vmcnt(" #n ")" ::: "memory")
#define PG8_WAIT_L(n) asm volatile("s_waitcnt lgkmcnt(" #n ")" ::: "memory")
#define PG8_BAR __builtin_amdgcn_s_barrier()
#define PG8_SCHED __builtin_amdgcn_sched_barrier(0)
    Unit cur, nxt; int ui = 0;
    if (!S.next(0, cur)) return;
    f32x4 acc[2][2][4][2];
#pragma unroll
    for (int a = 0; a < 2; ++a)
#pragma unroll
        for (int b = 0; b < 2; ++b)
#pragma unroll
            for (int m = 0; m < 4; ++m)
#pragma unroll
                for (int n = 0; n < 2; ++n) acc[a][b][m][n] = (f32x4){0.f, 0.f, 0.f, 0.f};
    bf16x8 At[4][2], B0[2][2], B1[2][2];
    const char* cA = (const char*)g.A + (size_t)cur.pm * tstep; const char* cB = (const char*)g.Bt + (size_t)cur.pn * tstep;
    S.a_ready(cur);
    if constexpr (SP2) {
        PG8_STAGE(PG8_SB(0, 0), cB, voffB); PG8_STAGE(PG8_SB(0, 1), cB + hstep, voffB); PG8_STAGE(PG8_SA(0, 0), cA, voffA); PG8_STAGE(PG8_SA(0, 1), cA + hstep, voffA);
        if (wr == 1) PG8_BAR;
        PG8_WAIT_V(2); PG8_BAR;
        PG8_STAGE(PG8_SB(1, 0), cB + kstep, voffB); PG8_STAGE(PG8_SA(1, 0), cA + kstep, voffA); PG8_STAGE(PG8_SB(1, 1), cB + hstep + kstep, voffB);
        PG8_WAIT_V(6); PG8_BAR;
    } else {
        PG8_STAGE(PG8_SB(0, 0), cB, voffB); PG8_STAGE(PG8_SA(0, 0), cA, voffA); PG8_STAGE(PG8_SB(0, 1), cB + hstep, voffB); PG8_STAGE(PG8_SA(0, 1), cA + hstep, voffA);
        if (wr == 1) PG8_BAR;
        PG8_WAIT_V(4); PG8_BAR;
        PG8_STAGE(PG8_SB(1, 0), cB + kstep, voffB); PG8_STAGE(PG8_SA(1, 0), cA + kstep, voffA); PG8_STAGE(PG8_SB(1, 1), cB + hstep + kstep, voffB);
        PG8_WAIT_V(6); PG8_BAR;
    }
    for (;;) {
        const bool has_next = S.next(ui + 1, nxt);
        const char* nA = has_next ? (const char*)g.A + (size_t)nxt.pm * tstep : cA; const char* nB = has_next ? (const char*)g.Bt + (size_t)nxt.pn * tstep : cB;
        for (int t = 0; t < nt; t += 2) {
            const bool last = (t == nt - 2);
            const char* a1 = cA + (size_t)(t + 1) * kstep;
            const char* a2 = last ? nA : cA + (size_t)(t + 2) * kstep; const char* b2 = last ? nB : cB + (size_t)(t + 2) * kstep;
            const char* a3 = a2 + kstep; const char* b3 = b2 + kstep;
            if (last && has_next) S.a_ready(nxt);
            if constexpr (SP2) {
            PG8_LDB(B0, 0, 0); PG8_LDB(B1, 0, 1); PG8_SCHED; PG8_LDA(At, 0, 0); PG8_STAGE(PG8_SA(1, 1), a1 + hstep, voffA);
            PG8_WAIT_V(8); PG8_WAIT_L(0); PG8_BAR; PG8_MMA(0, 0, At, B0); PG8_MMA(0, 1, At, B1); PG8_BAR; PG8_SCHED;
            PG8_LDA(At, 0, 1); PG8_STAGE(PG8_SB(0, 0), b2, voffB); PG8_STAGE(PG8_SB(0, 1), b2 + hstep, voffB); PG8_STAGE(PG8_SA(0, 0), a2, voffA);
            PG8_WAIT_V(8); PG8_WAIT_L(0); PG8_BAR; PG8_MMA(1, 0, At, B0); PG8_MMA(1, 1, At, B1); PG8_BAR; PG8_SCHED;
            PG8_LDB(B0, 1, 0); PG8_LDB(B1, 1, 1); PG8_SCHED; PG8_LDA(At, 1, 0); PG8_STAGE(PG8_SA(0, 1), a2 + hstep, voffA);
            PG8_WAIT_V(8); PG8_WAIT_L(0); PG8_BAR; PG8_MMA(0, 0, At, B0); PG8_MMA(0, 1, At, B1); PG8_BAR; PG8_SCHED;
            PG8_LDA(At, 1, 1); PG8_STAGE(PG8_SB(1, 0), b3, voffB); PG8_STAGE(PG8_SB(1, 1), b3 + hstep, voffB); PG8_STAGE(PG8_SA(1, 0), a3, voffA);
            PG8_WAIT_V(8); PG8_WAIT_L(0); PG8_BAR; PG8_MMA(1, 0, At, B0); PG8_MMA(1, 1, At, B1); PG8_BAR; PG8_SCHED;
            } else {
            PG8_LDB(B0, 0, 0); PG8_SCHED; PG8_LDA(At, 0, 0); PG8_STAGE(PG8_SA(1, 1), a1 + hstep, voffA);
            PG8_WAIT_L(8); PG8_BAR; PG8_WAIT_L(0); PG8_MMA(0, 0, At, B0); PG8_BAR; PG8_SCHED;
            PG8_LDB(B1, 0, 1); PG8_STAGE(PG8_SB(0, 0), b2, voffB);
            PG8_BAR; PG8_WAIT_L(0); PG8_MMA(0, 1, At, B1); PG8_BAR;
            PG8_LDA(At, 0, 1); PG8_STAGE(PG8_SA(0, 0), a2, voffA);
            PG8_BAR; PG8_WAIT_L(0); PG8_MMA(1, 0, At, B0); PG8_BAR; PG8_SCHED;
            PG8_STAGE(PG8_SB(0, 1), b2 + hstep, voffB);
            PG8_WAIT_V(6); PG8_BAR; PG8_MMA(1, 1, At, B1); PG8_BAR;
            PG8_LDB(B0, 1, 0); PG8_SCHED; PG8_LDA(At, 1, 0); PG8_STAGE(PG8_SA(0, 1), a2 + hstep, voffA);
            PG8_WAIT_L(8); PG8_BAR; PG8_WAIT_L(0); PG8_MMA(0, 0, At, B0); PG8_BAR; PG8_SCHED;
            PG8_LDB(B1, 1, 1); PG8_STAGE(PG8_SB(1, 0), b3, voffB);
            PG8_BAR; PG8_WAIT_L(0); PG8_MMA(0, 1, At, B1); PG8_BAR;
            PG8_LDA(At, 1, 1); PG8_STAGE(PG8_SA(1, 0), a3, voffA);
            PG8_BAR; PG8_WAIT_L(0); PG8_MMA(1, 0, At, B0); PG8_BAR; PG8_SCHED;
            PG8_STAGE(PG8_SB(1, 1), b3 + hstep, voffB);
            PG8_WAIT_V(6); PG8_BAR; PG8_MMA(1, 1, At, B1); PG8_BAR;
            }
        }
        if constexpr (ALIGN_EPI) { if (wr == 0) PG8_BAR; }
        { int fr_e = fr, fq_e = fq; asm volatile("" : "+v"(fr_e), "+v"(fq_e)); E(acc, cur, wr, wc, fr_e, fq_e); }
        S.done(cur);
        if (!has_next) break;
#pragma unroll
        for (int a = 0; a < 2; ++a)
#pragma unroll
            for (int b = 0; b < 2; ++b)
#pragma unroll
                for (int m = 0; m < 4; ++m)
#pragma unroll
                    for (int n = 0; n < 2; ++n) acc[a][b][m][n] = (f32x4){0.f, 0.f, 0.f, 0.f};
        cur = nxt; cA = nA; cB = nB; ++ui;
        if constexpr (ALIGN_EPI) { if (wr == 1) PG8_BAR; }
    }
    PG8_WAIT_V(0);
    if constexpr (!ALIGN_EPI) { if (wr == 0) PG8_BAR; }
    PG8_BAR;
#undef PG8_SA
#undef PG8_SB
#undef PG8_STAGE
#undef PG8_LDA
#undef PG8_LDB
#undef PG8_MMA
#undef PG8_WAIT_V
#undef PG8_WAIT_L
#undef PG8_BAR
#undef PG8_SCHED
}

struct EpiSwiGLU {
    static constexpr bool PERM = true;
    bf16_t* H; const float* SS; const float* bias;
    __device__ __forceinline__ void operator()(const f32x4 (&acc)[2][2][4][2], const Unit& u, int wr, int wc, int fr, int fq) const {
        const int mi = mod_index_of_tile(u.pm);
        const float* bp = bias + (size_t)mi * NFF + u.pn * 256 + wc * 32 + 8 * fq;
        f32x4 bv[2][2];
#pragma unroll
        for (int bj = 0; bj < 2; ++bj)
#pragma unroll
            for (int n = 0; n < 2; ++n) bv[bj][n] = *(const f32x4*)(bp + bj * 128 + 4 * n);
        const int row0 = u.pm * 256 + wr * 64 + fr;
        float rsv[2][4]; row_rstd16x8(SS, row0, fq, rsv);
#pragma unroll
        for (int ai = 0; ai < 2; ++ai)
#pragma unroll
            for (int m = 0; m < 4; ++m) {
                const int row = row0 + ai * 128 + m * 16;
                const float rs = rsv[ai][m];
                float h[8];
#pragma unroll
                for (int n = 0; n < 2; ++n) {
                    const f32x4 a = acc[ai][0][m][n] * rs + bv[0][n], b = acc[ai][1][m][n] * rs + bv[1][n];
                    const f32x4 t = a * -1.4426950408889634f;
                    f32x4 e; e.x = __builtin_amdgcn_exp2f(t.x); e.y = __builtin_amdgcn_exp2f(t.y); e.z = __builtin_amdgcn_exp2f(t.z); e.w = __builtin_amdgcn_exp2f(t.w);
                    const f32x4 d = e + 1.0f;
                    f32x4 r; r.x = fast_rcp(d.x); r.y = fast_rcp(d.y); r.z = fast_rcp(d.z); r.w = fast_rcp(d.w);
                    const f32x4 hv = (a * r) * b;
                    h[n * 4 + 0] = hv.x; h[n * 4 + 1] = hv.y; h[n * 4 + 2] = hv.z; h[n * 4 + 3] = hv.w;
                }
                u32x4 w; w.x = cvt_pk_bf16(h[0], h[1]); w.y = cvt_pk_bf16(h[2], h[3]); w.z = cvt_pk_bf16(h[4], h[5]); w.w = cvt_pk_bf16(h[6], h[7]);
                *(u32x4*)(H + (size_t)row * DFF + u.pn * 128 + wc * 32 + 8 * fq) = w;
            }
    }
};

struct EpiResid {
    static constexpr bool PERM = true;
    const float* xin_lat; const float* xin_ctx; const bf16_t* xin_bf; bf16_t* xout_bf; float* xout_f32; const float* gate; const float* gsn; bf16_t* AH; float* SS; float fac; int pad;
    template <bool IN_F32> __device__ __forceinline__ void body(const f32x4 (&acc)[2][2][4][2], const Unit& u, int wr, int wc, int fr, int fq) const {
        const int mi = mod_index_of_tile(u.pm);
        const int col0 = u.pn * 256 + wc * 32 + 8 * fq;
        f32x4 gv[2][2], sv[2][2];
#pragma unroll
        for (int bj = 0; bj < 2; ++bj)
#pragma unroll
            for (int n = 0; n < 2; ++n) {
                gv[bj][n] = *(const f32x4*)(gate + (size_t)mi * NMOD + col0 + bj * 128 + 4 * n) * fac;
                sv[bj][n] = gsn ? *(const f32x4*)(gsn + (size_t)mi * DM + col0 + bj * 128 + 4 * n) : (f32x4){0.f, 0.f, 0.f, 0.f};
            }
        const int row0 = u.pm * 256 + wr * 64 + fr;
        constexpr int NBUF = 3;
        f32x4 xf[IN_F32 ? NBUF : 1][2][2];
        u32x4 xb[IN_F32 ? 1 : NBUF][2];
#define RES_LOAD(g, buf) do { const int row_ = row0 + ((g) >> 2) * 128 + ((g) & 3) * 16; \
            if constexpr (IN_F32) { const float* xp_ = (row_ < ML) ? xin_lat + (size_t)row_ * DM : xin_ctx + (size_t)(row_ - ML) * DM; \
                _Pragma("unroll") for (int bj = 0; bj < 2; ++bj) { xf[buf][bj][0] = *(const f32x4*)(xp_ + col0 + bj * 128); xf[buf][bj][1] = *(const f32x4*)(xp_ + col0 + bj * 128 + 4); } } \
            else { _Pragma("unroll") for (int bj = 0; bj < 2; ++bj) xb[buf][bj] = *(const u32x4*)(xin_bf + (size_t)row_ * DM + col0 + bj * 128); } } while (0)
#pragma unroll
        for (int g = 0; g < NBUF - 1; ++g) RES_LOAD(g, g);
#pragma unroll
        for (int g = 0; g < 8; ++g) {
            const int ai = g >> 2, m = g & 3;
            if (g + NBUF - 1 < 8) RES_LOAD(g + NBUF - 1, (g + NBUF - 1) % NBUF);
            const int row = row0 + ai * 128 + m * 16;
            float ssq = 0.f;
#pragma unroll
            for (int bj = 0; bj < 2; ++bj) {
                f32x4 x0, x1;
                if constexpr (IN_F32) { x0 = xf[g % NBUF][bj][0]; x1 = xf[g % NBUF][bj][1]; }
                else { const u32x4 w = xb[g % NBUF][bj]; const f32x2 p0 = unpk_h2(w.x), p1 = unpk_h2(w.y), p2 = unpk_h2(w.z), p3 = unpk_h2(w.w); x0 = (f32x4){p0.x, p0.y, p1.x, p1.y}; x1 = (f32x4){p2.x, p2.y, p3.x, p3.y}; }
                const f32x4 y0 = x0 + gv[bj][0] * acc[ai][bj][m][0], y1 = x1 + gv[bj][1] * acc[ai][bj][m][1];
                if (xout_f32) { float* op = xout_f32 + (size_t)row * DM; *(f32x4*)(op + col0 + bj * 128) = y0; *(f32x4*)(op + col0 + bj * 128 + 4) = y1; }
                else { u32x4 w; w.x = pk_h2(y0.x, y0.y); w.y = pk_h2(y0.z, y0.w); w.z = pk_h2(y1.x, y1.y); w.w = pk_h2(y1.z, y1.w);
                    *(u32x4*)(xout_bf + (size_t)row * DM + col0 + bj * 128) = w; }
                ssq += (y0.x * y0.x + y0.y * y0.y) + (y0.z * y0.z + y0.w * y0.w) + (y1.x * y1.x + y1.y * y1.y) + (y1.z * y1.z + y1.w * y1.w);
                if (gsn) {
                    const f32x4 a0 = y0 * sv[bj][0], a1 = y1 * sv[bj][1];
                    u32x4 w; w.x = cvt_pk_bf16(a0.x, a0.y); w.y = cvt_pk_bf16(a0.z, a0.w); w.z = cvt_pk_bf16(a1.x, a1.y); w.w = cvt_pk_bf16(a1.z, a1.w);
                    *(u32x4*)(AH + (size_t)row * DM + col0 + bj * 128) = w;
                }
            }
            if (gsn) {
                ssq += __shfl_xor(ssq, 16); ssq += __shfl_xor(ssq, 32);
                if (fq == 0) SS[(size_t)row * 16 + u.pn * 4 + wc] = ssq;
            }
        }
#undef RES_LOAD
    }
    __device__ __forceinline__ void operator()(const f32x4 (&acc)[2][2][4][2], const Unit& u, int wr, int wc, int fr, int fq) const {
        if (xin_bf) body<false>(acc, u, wr, wc, fr, fq); else body<true>(acc, u, wr, wc, fr, fq);
    }
};

struct EpiInA {
    static constexpr bool PERM = false;
    const float* SS; const float* bias; const float* qkg; const float* rope; bf16_t* Q; bf16_t* KB; bf16_t* VB; bf16_t* P;
    __device__ __forceinline__ void operator()(const f32x4 (&acc)[2][2][4][2], const Unit& u, int wr, int wc, int fr, int fq) const {
        const int mi = mod_index_of_tile(u.pm);
        const int row0 = u.pm * 256 + wr * 64 + fr;
        float rsv[2][4]; row_rstd16x8(SS, row0, fq, rsv);
        asm volatile("" : "+v"(rsv[0][0]), "+v"(rsv[0][1]), "+v"(rsv[0][2]), "+v"(rsv[0][3]), "+v"(rsv[1][0]), "+v"(rsv[1][1]), "+v"(rsv[1][2]), "+v"(rsv[1][3]) :: "memory");
        const float* bp = bias + (size_t)mi * NFF + u.pn * 256 + wc * 32 + 4 * fq;
        f32x4 bv[2][2];
#pragma unroll
        for (int bj = 0; bj < 2; ++bj)
#pragma unroll
            for (int n = 0; n < 2; ++n) bv[bj][n] = *(const f32x4*)(bp + bj * 128 + 16 * n);
        if (u.pn >= 3) {
#pragma unroll
            for (int ai = 0; ai < 2; ++ai)
#pragma unroll
                for (int m = 0; m < 4; ++m) {
                    const int row = row0 + ai * 128 + m * 16;
                    const float rs = rsv[ai][m];
                    bf16_t* pp = P + (size_t)row * 512 + (u.pn - 3) * 256 + wc * 32 + 4 * fq;
#pragma unroll
                    for (int bj = 0; bj < 2; ++bj)
#pragma unroll
                        for (int n = 0; n < 2; ++n) { const f32x4 v = acc[ai][bj][m][n] * rs + bv[bj][n]; u32x2 w; w.x = cvt_pk_bf16(v.x, v.y); w.y = cvt_pk_bf16(v.z, v.w); *(u32x2*)(pp + bj * 128 + 16 * n) = w; }
                }
            return;
        }
        const bool isv = (u.pn == 2 && wc >= 2), isk = (u.pn == 2 && wc < 2);
        const int head = (u.pn < 2) ? (u.pn * 4 + wc) : (wc & 1);
        f32x4 gq[2][2];
#pragma unroll
        for (int bj = 0; bj < 2; ++bj)
#pragma unroll
            for (int n = 0; n < 2; ++n) gq[bj][n] = *(const f32x4*)(qkg + (isk ? 64 : 0) + 32 * bj + 16 * n + 4 * fq);
#pragma unroll
        for (int ai = 0; ai < 2; ++ai)
#pragma unroll
            for (int m = 0; m < 4; ++m) {
                const int row = row0 + ai * 128 + m * 16;
                const float rs = rsv[ai][m];
                f32x4 v[2][2];
#pragma unroll
                for (int bj = 0; bj < 2; ++bj)
#pragma unroll
                    for (int n = 0; n < 2; ++n) v[bj][n] = acc[ai][bj][m][n] * rs + bv[bj][n];
                const bool lat = row < ML;
                const int kvb = lat ? (row >> 13) : ((row - ML) >> 8), kvi = lat ? (CTXL + (row & 8191)) : ((row - ML) & 255);
                if (!isv) {
                    float ss = 0.f;
#pragma unroll
                    for (int bj = 0; bj < 2; ++bj)
#pragma unroll
                        for (int n = 0; n < 2; ++n) ss += (v[bj][n].x * v[bj][n].x + v[bj][n].y * v[bj][n].y) + (v[bj][n].z * v[bj][n].z + v[bj][n].w * v[bj][n].w);
                    ss += __shfl_xor(ss, 16); ss += __shfl_xor(ss, 32);
                    const float r = 1.0f / sqrtf(ss * (1.0f / 64.0f) + EPS);
#pragma unroll
                    for (int bj = 0; bj < 2; ++bj)
#pragma unroll
                        for (int n = 0; n < 2; ++n) v[bj][n] = v[bj][n] * r * gq[bj][n];
                    if (lat) {
                        const int t = row & 8191;
#pragma unroll
                        for (int bj = 0; bj < 2; ++bj) {
                            const int pos = bj == 0 ? (t >> 6) : (t & 63);
                            const f32x4 cs0 = *(const f32x4*)(rope + (size_t)pos * 32 + 8 * fq), cs1 = *(const f32x4*)(rope + (size_t)pos * 32 + 8 * fq + 4);
                            const f32x4 c = (f32x4){cs0.x, cs0.z, cs1.x, cs1.z}, s = (f32x4){cs0.y, cs0.w, cs1.y, cs1.w};
                            const f32x4 x1 = v[bj][0], x2 = v[bj][1];
                            v[bj][0] = x1 * c - x2 * s; v[bj][1] = x1 * s + x2 * c;
                        }
                    }
                    if (!isk) {
#pragma unroll
                        for (int bj = 0; bj < 2; ++bj)
#pragma unroll
                            for (int n = 0; n < 2; ++n) v[bj][n] = v[bj][n] * QSCALE;
                    }
                }
                bf16_t* dst = (u.pn < 2) ? (Q + (size_t)row * 512 + head * 64) : ((isk ? KB : VB) + ((size_t)(kvb * 2 + head) * KVROWS + kvi) * 64);
                dst += 4 * fq;
#pragma unroll
                for (int bj = 0; bj < 2; ++bj)
#pragma unroll
                    for (int n = 0; n < 2; ++n) { u32x2 w; w.x = cvt_pk_bf16(v[bj][n].x, v[bj][n].y); w.y = cvt_pk_bf16(v[bj][n].z, v[bj][n].w); *(u32x2*)(dst + 32 * bj + 16 * n) = w; }
            }
    }
};

struct EpiInC {
    static constexpr bool PERM = true;
    const float* SS; const float* bias; bf16_t* U; bf16_t* V; float* VSS;
    __device__ __forceinline__ void operator()(const f32x4 (&acc)[2][2][4][2], const Unit& u, int wr, int wc, int fr, int fq) const {
        const int mi = mod_index_of_tile(u.pm);
        const float* bp = bias + (size_t)mi * NFF + u.pn * 256 + wc * 32 + 8 * fq;
        f32x4 bv[2][2];
#pragma unroll
        for (int bj = 0; bj < 2; ++bj)
#pragma unroll
            for (int n = 0; n < 2; ++n) bv[bj][n] = *(const f32x4*)(bp + bj * 128 + 4 * n);
        const int row0 = u.pm * 256 + wr * 64 + fr;
        const bool isv = u.pn >= 4;
        bf16_t* base = isv ? V : U;
        const int ctile = (u.pn & 3) * 256 + wc * 32 + 8 * fq;
        float rsv[2][4]; row_rstd16x8(SS, row0, fq, rsv);
#pragma unroll
        for (int ai = 0; ai < 2; ++ai)
#pragma unroll
            for (int m = 0; m < 4; ++m) {
                const int row = row0 + ai * 128 + m * 16;
                const float rs = rsv[ai][m];
                float ssq = 0.f;
#pragma unroll
                for (int bj = 0; bj < 2; ++bj) {
                    float z[8];
#pragma unroll
                    for (int n = 0; n < 2; ++n)
#pragma unroll
                        for (int j = 0; j < 4; ++j) { z[n * 4 + j] = gelu_tanh_f(acc[ai][bj][m][n][j] * rs + bv[bj][n][j]); ssq += z[n * 4 + j] * z[n * 4 + j]; }
                    u32x4 w; w.x = cvt_pk_bf16(z[0], z[1]); w.y = cvt_pk_bf16(z[2], z[3]); w.z = cvt_pk_bf16(z[4], z[5]); w.w = cvt_pk_bf16(z[6], z[7]);
                    *(u32x4*)(base + (size_t)row * DM + ctile + bj * 128) = w;
                }
                if (isv) {
                    ssq += __shfl_xor(ssq, 16); ssq += __shfl_xor(ssq, 32);
                    if (fq == 0) VSS[(size_t)row * 16 + (u.pn - 4) * 4 + wc] = ssq;
                }
            }
    }
};
}

namespace attn_body {
using bf16 = __hip_bfloat16;
using s16x4 = __attribute__((ext_vector_type(4))) short;
using f32x16 = __attribute__((ext_vector_type(16))) float;
constexpr int D = 64, NW = 8, QBLK = 32, QB = QBLK * NW, KVBLK = 64;
constexpr int QP = 512, KVP = 64, OP = 1024;
__device__ __forceinline__ int crow(int r, int hi) { return (r & 3) + 8 * (r >> 2) + 4 * hi; }
#define SBAR() __builtin_amdgcn_sched_barrier(0)
constexpr int NSLOT = 3, SLOTB = 8192;
constexpr int LDS_K = 0, LDS_V = NSLOT * SLOTB, LDS_WS = 2 * NSLOT * SLOTB, LDS_OST = LDS_WS + NW * 64 * 4, LDS_BYTES_A = LDS_OST + NW * 4096;
__device__ __forceinline__ void glds16(const void* gsrc, unsigned lds_dst) { unsigned keep;
    asm volatile("s_mov_b32 %0, m0\n\ts_mov_b32 m0, %2\n\ts_nop 0\n\tglobal_load_lds_dwordx4 %1, off\n\ts_mov_b32 m0, %0" : "=&s"(keep) : "v"(gsrc), "s"(lds_dst) : "memory"); }
__device__ __forceinline__ float max3f(float a, float b, float c) { float r; asm("v_max3_f32 %0, %1, %2, %3" : "=v"(r) : "v"(a), "v"(b), "v"(c)); return r; }
__device__ __forceinline__ float max2f(float a, float b) { float r; asm("v_max_f32_e32 %0, %1, %2" : "=v"(r) : "v"(a), "v"(b)); return r; }
__device__ __forceinline__ float fadd_s(float a, float b) { float r; asm("v_add_f32_e32 %0, %1, %2" : "=v"(r) : "v"(a), "v"(b)); return r; }
__device__ __forceinline__ float fsub_s(float a, float b) { float r; asm("v_sub_f32_e32 %0, %1, %2" : "=v"(r) : "v"(a), "v"(b)); return r; }
typedef float f32x2_t __attribute__((ext_vector_type(2))); typedef __bf16 bf16x2_t __attribute__((ext_vector_type(2)));
__device__ __forceinline__ unsigned cvtpk_s(float lo, float hi) { f32x2_t v = {lo, hi}; bf16x2_t b = __builtin_convertvector(v, bf16x2_t); return __builtin_bit_cast(unsigned, b); }
#define WAIT_BAR(N) asm volatile("s_waitcnt vmcnt(" #N ") lgkmcnt(0)\n\ts_barrier" ::: "memory")
__device__ __forceinline__ void qkt(f32x16& p0, f32x16& p1, const char* Kslot, const bf16x8* qr, const f32x16& negm, int r32, int hi) {
    const char* kb = Kslot + hi * 1024 + r32 * 16;
#pragma unroll
    for (int d0 = 0; d0 < 4; ++d0) {
        const bf16x8 b0 = *reinterpret_cast<const bf16x8*>(kb + d0 * 2048);
        const bf16x8 b1 = *reinterpret_cast<const bf16x8*>(kb + d0 * 2048 + 512);
        if (d0 == 0) { p0 = __builtin_amdgcn_mfma_f32_32x32x16_bf16(b0, qr[0], negm, 0, 0, 0); p1 = __builtin_amdgcn_mfma_f32_32x32x16_bf16(b1, qr[0], negm, 0, 0, 0); }
        else { p0 = __builtin_amdgcn_mfma_f32_32x32x16_bf16(b0, qr[d0], p0, 0, 0, 0); p1 = __builtin_amdgcn_mfma_f32_32x32x16_bf16(b1, qr[d0], p1, 0, 0, 0); } }
}
typedef __attribute__((address_space(3))) const char* lds_cptr;
typedef short v4i16_t __attribute__((ext_vector_type(4)));
__device__ __forceinline__ void kload8(bf16x8* kf, lds_cptr kp) {
    kf[0] = *(const LAS bf16x8*)(kp);        kf[1] = *(const LAS bf16x8*)(kp + 512);
    kf[2] = *(const LAS bf16x8*)(kp + 2048); kf[3] = *(const LAS bf16x8*)(kp + 2560);
    kf[4] = *(const LAS bf16x8*)(kp + 4096); kf[5] = *(const LAS bf16x8*)(kp + 4608);
    kf[6] = *(const LAS bf16x8*)(kp + 6144); kf[7] = *(const LAS bf16x8*)(kp + 6656);
}
__device__ __forceinline__ void kload2(bf16x8* kf, lds_cptr kp, int j) { kf[2 * j] = *(const LAS bf16x8*)(kp + j * 2048); kf[2 * j + 1] = *(const LAS bf16x8*)(kp + j * 2048 + 512); }
__device__ __forceinline__ s16x4 vtr(lds_cptr p) { return __builtin_bit_cast(s16x4, __builtin_amdgcn_ds_read_tr16_b64_v4i16((LAS v4i16_t*)p)); }
__device__ __forceinline__ float rowmax(const f32x16& p0, const f32x16& p1) {
    float a = max3f(p0[0], p0[1], p1[0]), b = max3f(p0[2], p0[3], p1[1]); a = max3f(a, p1[2], p1[3]);
#pragma unroll
    for (int r = 4; r < 16; r += 4) { a = max3f(a, p0[r], p0[r + 1]); b = max3f(b, p0[r + 2], p0[r + 3]); a = max3f(a, p1[r], p1[r + 1]); b = max3f(b, p1[r + 2], p1[r + 3]); }
    const float m = max2f(a, b);
    auto rr = __builtin_amdgcn_permlane32_swap(__float_as_uint(m), __float_as_uint(m), false, false);
    return max2f(__uint_as_float(rr[0]), __uint_as_float(rr[1]));
}
__device__ __forceinline__ void pv(f32x16* o, int vb, bf16x8 pa0, bf16x8 pa1, bf16x8 pa2, bf16x8 pa3) {
#pragma unroll
    for (int d0 = 0; d0 < 2; ++d0) { s16x4 lo[4], hi[4];
#pragma unroll
        for (int ks = 0; ks < 4; ++ks) {
            asm volatile("ds_read_b64_tr_b16 %0,%1 offset:%c2" : "=&v"(lo[ks]) : "v"(vb), "i"(d0 * 4096 + ks * 1024) : "memory");
            asm volatile("ds_read_b64_tr_b16 %0,%1 offset:%c2" : "=&v"(hi[ks]) : "v"(vb), "i"(d0 * 4096 + ks * 1024 + 512) : "memory"); }
        asm volatile("s_waitcnt lgkmcnt(0)" ::: "memory"); SBAR();
#define PK(k) (bf16x8){lo[k][0], lo[k][1], lo[k][2], lo[k][3], hi[k][0], hi[k][1], hi[k][2], hi[k][3]}
        o[d0] = __builtin_amdgcn_mfma_f32_32x32x16_bf16(pa0, PK(0), o[d0], 0, 0, 0);
        o[d0] = __builtin_amdgcn_mfma_f32_32x32x16_bf16(pa1, PK(1), o[d0], 0, 0, 0);
        o[d0] = __builtin_amdgcn_mfma_f32_32x32x16_bf16(pa2, PK(2), o[d0], 0, 0, 0);
        o[d0] = __builtin_amdgcn_mfma_f32_32x32x16_bf16(pa3, PK(3), o[d0], 0, 0, 0);
#undef PK
    }
}

template <int THRL> __device__ __forceinline__ void attn_unit(const bf16* Qu, const bf16* __restrict__ Kh, const bf16* __restrict__ Vh, const int NT, bf16* Ou, char* shm) {
    int tid_ = threadIdx.x; asm volatile("" : "+v"(tid_));
    const int tid = tid_, lane = tid & 63, r32 = lane & 31, hi = lane >> 5; const int wid = __builtin_amdgcn_readfirstlane(tid >> 6);
    const bf16* Qw = Qu + (long)(wid * QBLK) * QP;
    const unsigned lds0 = (unsigned)(uintptr_t)shm;
    float* wsf = (float*)(shm + LDS_WS) + wid * 64;
    const bf16* ksrc = Kh + (long)lane * KVP + wid * 8;
    const bf16* vsrc = Vh + (long)(16 * (wid & 3) + (lane >> 2)) * KVP + (wid >> 2) * 32 + (lane & 3) * 8;
    const unsigned kdst = lds0 + LDS_K + wid * 1024, vdst = lds0 + LDS_V + wid * 1024;
#define DMA_K(t, slot) glds16(ksrc + (long)(t) * KVBLK * KVP, (unsigned)__builtin_amdgcn_readfirstlane(kdst + (slot)))
#define DMA_V(t, slot) glds16(vsrc + (long)(t) * KVBLK * KVP, (unsigned)__builtin_amdgcn_readfirstlane(vdst + (slot)))
    const int vb0 = (int)(lds0 + LDS_V) + ((lane >> 4) & 1) * 32 + (lane & 3) * 8 + (4 * hi + ((lane & 15) >> 2)) * 64;
    const char* Kbase = shm + LDS_K; bf16x8 kf[8];
    const lds_cptr shm3 = (lds_cptr)shm; const lds_cptr kp0 = shm3 + LDS_K + hi * 1024 + r32 * 16; const lds_cptr vp0 = shm3 + LDS_V + ((lane >> 4) & 1) * 32 + (lane & 3) * 8 + (4 * hi + ((lane & 15) >> 2)) * 64;
    DMA_K(0, 0); DMA_V(0, 0); DMA_K(1, SLOTB);
    bf16x8 qr[4];
#pragma unroll
    for (int d0 = 0; d0 < 4; ++d0) qr[d0] = *reinterpret_cast<const bf16x8*>(&Qw[(long)r32 * QP + d0 * 16 + hi * 8]);
    float mhat = 0.f, l_reg = 0.f; f32x16 o[2]; o[0] = f32x16{}; o[1] = f32x16{}; f32x16 negm = f32x16{}; asm volatile("" : "+v"(negm));
    bool resc = false;
#define START(P0, P1) do { const float rm = rowmax(P0, P1); resc = false; \
    { const float dl = rm; mhat = fadd_s(mhat, dl); \
      _Pragma("unroll") for (int r = 0; r < 16; ++r) { P0[r] = fsub_s(P0[r], dl); P1[r] = fsub_s(P1[r], dl); } \
      _Pragma("unroll") for (int r = 0; r < 16; ++r) negm[r] = -mhat; asm volatile("" : "+v"(negm)); } \
    _Pragma("unroll") for (int r = 0; r < 16; ++r) P0[r] = __builtin_amdgcn_exp2f(P0[r]); } while (0)
#define RESC() do { if (resc) { asm volatile("s_waitcnt lgkmcnt(0)" ::: "memory"); \
      _Pragma("unroll") for (int d_ = 0; d_ < 2; ++d_) _Pragma("unroll") for (int r = 0; r < 16; ++r) o[d_][r] *= wsf[crow(r, hi)]; } } while (0)
    f32x16 pA0, pA1, pB0, pB1;
    int sl_prev = 0, sl_cur = 0, sl_next = SLOTB;
#define ROT() do { sl_prev = sl_cur; sl_cur = sl_next; sl_next = (sl_next == (NSLOT - 1) * SLOTB) ? 0 : sl_next + SLOTB; } while (0)
    DMA_K(2, 2 * SLOTB);
    WAIT_BAR(3);
    qkt(pA0, pA1, Kbase, qr, negm, r32, hi); asm volatile("s_nop 15\n\ts_nop 7" : "+v"(pA0), "+v"(pA1));
    START(pA0, pA1);
    _Pragma("unroll") for (int r = 0; r < 16; ++r) pA1[r] = __builtin_amdgcn_exp2f(pA1[r]);
    WAIT_BAR(0);
    DMA_K(3, 0); DMA_V(1, SLOTB);
    ROT();
    kload8(kf, kp0 + sl_cur);
    WAIT_BAR(2);
    s16x4 vlo[8], vhi[8]; u32x4 pw0, pw1, pw2, pw3;
#define PKW(P, B) cvtpk_s(P[B], P[B + 1])
#define PAF(k) __builtin_bit_cast(bf16x8, pw##k)
#define VFR(i) (bf16x8){vlo[i][0], vlo[i][1], vlo[i][2], vlo[i][3], vhi[i][0], vhi[i][1], vhi[i][2], vhi[i][3]}
#define PIN(x) asm volatile("" : "+v"(x))
#define MX3(a, b, c) __builtin_fmaxf(__builtin_fmaxf((a), (b)), (c))
#define GAPA(MF, A0, A1, A2, A3, W0, W1, PW) do { MF; sacc += A0; sacc += A1; sacc += A2; sacc += A3; PIN(sacc); W0; W1; PIN(PW); SBAR(); } while (0)
#define EX(v) __builtin_amdgcn_exp2f(v)
#define GAPB(MF, X, B) do { MF; X[B] = EX(X[B]); X[B + 1] = EX(X[B + 1]); X[B + 2] = EX(X[B + 2]); X[B + 3] = EX(X[B + 3]); PIN(X); SBAR(); } while (0)
#define VRD(i) do { vlo[i] = vtr(vp_ + (((i) >> 2) * 4096 + ((i) & 3) * 1024)); vhi[i] = vtr(vp_ + (((i) >> 2) * 4096 + ((i) & 3) * 1024 + 512)); } while (0)
#define KRD(G, j) do { if (G) { kload2(kf, kp0 + sl_next, j); SBAR(); } } while (0)
#define STEP(C0, C1, P0, P1, t, GK, GV, GL, CHK) do { SBAR(); \
    const lds_cptr vp_ = vp0 + sl_prev; \
    VRD(0); SBAR(); float sacc = (P0[0] + P0[1]); \
    GAPA(C0 = __builtin_amdgcn_mfma_f32_32x32x16_bf16(kf[0], qr[0], negm, 0, 0, 0), P0[2], P0[3], P0[4], P0[5],     pw0[0] = PKW(P0, 0), pw0[1] = PKW(P0, 2), pw0); \
    VRD(4); SBAR(); GAPA(C1 = __builtin_amdgcn_mfma_f32_32x32x16_bf16(kf[1], qr[0], negm, 0, 0, 0), P0[6], P0[7], P0[8], P0[9],     pw0[2] = PKW(P0, 4), pw0[3] = PKW(P0, 6), pw0); \
    VRD(1); SBAR(); GAPA(C0 = __builtin_amdgcn_mfma_f32_32x32x16_bf16(kf[2], qr[1], C0, 0, 0, 0),   P0[10], P0[11], P0[12], P0[13], pw1[0] = PKW(P0, 8), pw1[1] = PKW(P0, 10), pw1); \
    VRD(5); SBAR(); GAPA(C1 = __builtin_amdgcn_mfma_f32_32x32x16_bf16(kf[3], qr[1], C1, 0, 0, 0),   P0[14], P0[15], P1[0], P1[1],   pw1[2] = PKW(P0, 12), pw1[3] = PKW(P0, 14), pw1); \
    VRD(2); SBAR(); GAPA(C0 = __builtin_amdgcn_mfma_f32_32x32x16_bf16(kf[4], qr[2], C0, 0, 0, 0),   P1[2], P1[3], P1[4], P1[5],     pw2[0] = PKW(P1, 0), pw2[1] = PKW(P1, 2), pw2); \
    VRD(6); SBAR(); GAPA(C1 = __builtin_amdgcn_mfma_f32_32x32x16_bf16(kf[5], qr[2], C1, 0, 0, 0),   P1[6], P1[7], P1[8], P1[9],     pw2[2] = PKW(P1, 4), pw2[3] = PKW(P1, 6), pw2); \
    VRD(3); SBAR(); GAPA(C0 = __builtin_amdgcn_mfma_f32_32x32x16_bf16(kf[6], qr[3], C0, 0, 0, 0),   P1[10], P1[11], P1[12], P1[13], pw3[0] = PKW(P1, 8), pw3[1] = PKW(P1, 10), pw3); \
    VRD(7); SBAR(); GAPA(C1 = __builtin_amdgcn_mfma_f32_32x32x16_bf16(kf[7], qr[3], C1, 0, 0, 0),   P1[14], P1[15], 0.f, 0.f,       pw3[2] = PKW(P1, 12), pw3[3] = PKW(P1, 14), pw3); \
    l_reg += sacc; \
    if (GK) { DMA_K((t) + 3, sl_cur); } if (GV) { DMA_V((t) + 1, sl_next); } \
    resc = false; \
    if (CHK) { float a = MX3(C0[0], C0[1], C1[0]), b = MX3(C0[2], C0[3], C1[1]); a = MX3(a, C1[2], C1[3]); \
      _Pragma("unroll") for (int r = 4; r < 16; r += 4) { a = MX3(a, C0[r], C0[r + 1]); b = MX3(b, C0[r + 2], C0[r + 3]); a = MX3(a, C1[r], C1[r + 1]); b = MX3(b, C1[r + 2], C1[r + 3]); } \
      float rm = __builtin_fmaxf(a, b); { auto rr = __builtin_amdgcn_permlane32_swap(__float_as_uint(rm), __float_as_uint(rm), false, false); rm = __builtin_fmaxf(__uint_as_float(rr[0]), __uint_as_float(rr[1])); } \
      if (__builtin_expect(__any(rm > (float)THRL), 0)) { const float dl = __builtin_fmaxf(rm, 0.f); mhat += dl; \
        _Pragma("unroll") for (int r = 0; r < 16; ++r) { C0[r] -= dl; C1[r] -= dl; } \
        _Pragma("unroll") for (int r = 0; r < 16; ++r) negm[r] = -mhat; asm volatile("" : "+v"(negm)); \
        const float f = __builtin_amdgcn_exp2f(-dl); l_reg *= f; if (hi == 0) wsf[r32] = f; resc = true; } } \
    SBAR(); \
    GAPB(o[0] = __builtin_amdgcn_mfma_f32_32x32x16_bf16(PAF(0), VFR(0), o[0], 0, 0, 0), C0, 0); \
    GAPB(o[1] = __builtin_amdgcn_mfma_f32_32x32x16_bf16(PAF(0), VFR(4), o[1], 0, 0, 0), C0, 4); \
    KRD(GL, 0); GAPB(o[0] = __builtin_amdgcn_mfma_f32_32x32x16_bf16(PAF(1), VFR(1), o[0], 0, 0, 0), C0, 8); \
    KRD(GL, 1); GAPB(o[1] = __builtin_amdgcn_mfma_f32_32x32x16_bf16(PAF(1), VFR(5), o[1], 0, 0, 0), C0, 12); \
    KRD(GL, 2); GAPB(o[0] = __builtin_amdgcn_mfma_f32_32x32x16_bf16(PAF(2), VFR(2), o[0], 0, 0, 0), C1, 0); \
    KRD(GL, 3); GAPB(o[1] = __builtin_amdgcn_mfma_f32_32x32x16_bf16(PAF(2), VFR(6), o[1], 0, 0, 0), C1, 4); \
    GAPB(o[0] = __builtin_amdgcn_mfma_f32_32x32x16_bf16(PAF(3), VFR(3), o[0], 0, 0, 0), C1, 8); \
    GAPB(o[1] = __builtin_amdgcn_mfma_f32_32x32x16_bf16(PAF(3), VFR(7), o[1], 0, 0, 0), C1, 12); \
    } while (0)
    int t = 1;
    for (; t + 5 < NT; t += 2) {
        STEP(pB0, pB1, pA0, pA1, t, true, true, true, true);      WAIT_BAR(2); RESC(); ROT();
        STEP(pA0, pA1, pB0, pB1, t + 1, true, true, true, false); WAIT_BAR(2); RESC(); ROT();
    }
#define ENDW(tt) do { if ((tt) + 3 < NT) { WAIT_BAR(2); } else if ((tt) + 2 < NT) { WAIT_BAR(1); } else { WAIT_BAR(0); } } while (0)
    for (; t + 1 < NT; t += 2) {
        STEP(pB0, pB1, pA0, pA1, t, (t + 3 < NT), (t + 1 < NT), (t + 1 < NT), true);       ENDW(t);     RESC(); ROT();
        STEP(pA0, pA1, pB0, pB1, t + 1, (t + 4 < NT), (t + 2 < NT), (t + 2 < NT), true);   ENDW(t + 1); RESC(); ROT();
    }
    STEP(pB0, pB1, pA0, pA1, NT - 1, false, false, false, true); RESC();
    { float sacc = pB0[0] + pB0[1]; _Pragma("unroll") for (int r = 2; r < 16; ++r) sacc += pB0[r]; _Pragma("unroll") for (int r = 0; r < 16; ++r) sacc += pB1[r]; l_reg += sacc;
      pw0 = (u32x4){PKW(pB0, 0), PKW(pB0, 2), PKW(pB0, 4), PKW(pB0, 6)}; pw1 = (u32x4){PKW(pB0, 8), PKW(pB0, 10), PKW(pB0, 12), PKW(pB0, 14)}; pw2 = (u32x4){PKW(pB1, 0), PKW(pB1, 2), PKW(pB1, 4), PKW(pB1, 6)}; pw3 = (u32x4){PKW(pB1, 8), PKW(pB1, 10), PKW(pB1, 12), PKW(pB1, 14)};
      SBAR(); pv(o, vb0 + sl_cur, PAF(0), PAF(1), PAF(2), PAF(3)); }
#undef PKW
#undef PAF
#undef VFR
#undef PIN
#undef MX3
#undef GAPA
#undef GAPB
#undef EX
#undef VRD
#undef KRD
#undef STEP
#undef ENDW
    { auto rr = __builtin_amdgcn_permlane32_swap(__float_as_uint(l_reg), __float_as_uint(l_reg), false, false); l_reg = __uint_as_float(rr[0]) + __uint_as_float(rr[1]); }
    if (hi == 0) wsf[32 + r32] = l_reg; asm volatile("s_waitcnt lgkmcnt(0)" ::: "memory");
    float rli[16];
#pragma unroll
    for (int r = 0; r < 16; ++r) rli[r] = __builtin_amdgcn_rcpf(wsf[32 + crow(r, hi)]);
    bf16* Ow = Ou + (long)(wid * QBLK) * OP;
    { bf16* stg = (bf16*)(shm + LDS_OST) + wid * 2048;
#pragma unroll
      for (int r = 0; r < 16; ++r) { const int orow = crow(r, hi);
#pragma unroll
        for (int d0 = 0; d0 < 2; ++d0) stg[orow * 64 + d0 * 32 + r32] = __float2bfloat16(o[d0][r] * rli[r]); }
      asm volatile("s_waitcnt lgkmcnt(0)" ::: "memory");
#pragma unroll
      for (int i = 0; i < 4; ++i) { const int row = i * 8 + (lane >> 3), ch = lane & 7; const u32x4 v = *(const u32x4*)(stg + row * 64 + ch * 8); *(u32x4*)(Ow + (long)row * OP + ch * 8) = v; } }
    asm volatile("s_waitcnt lgkmcnt(0)\n\ts_barrier" ::: "memory");
#undef DMA_K
#undef DMA_V
#undef START
#undef RESC
#undef ROT
}
#undef SBAR
#undef WAIT_BAR
}

template <int KS> __device__ __forceinline__ void ctx_gemm_resid(LAS unsigned char* lds, const bf16_t* A, const bf16_t* Wt, const pg8::EpiResid& E, int tile) {
    int tid_ = threadIdx.x; asm volatile("" : "+v"(tid_));
    const int tid = tid_, lane = tid & 63, wave = __builtin_amdgcn_readfirstlane(tid >> 6), fr = lane & 15, fq = lane >> 4;
    constexpr int K = KS * 256;
    const int rt = tile >> 4, ct = tile & 15, row0 = ML + rt * 32, col0 = ct * 64;
    const bf16_t* ap = A + (size_t)(row0 + fr) * K + wave * (KS * 32) + 8 * fq;
    const bf16_t* bp = Wt + (size_t)(col0 + fr) * K + wave * (KS * 32) + 8 * fq;
    const int erow = row0 + (tid >> 4), ecol = col0 + 4 * (tid & 15);
    const f32x4 e_gate = *(const f32x4*)(E.gate + (size_t)2 * NMOD + ecol);
    f32x4 e_x;
    if (E.xin_bf) { const u32x2 w = *(const u32x2*)(E.xin_bf + (size_t)erow * DM + ecol); const f32x2 p0 = unpk_h2(w.x), p1 = unpk_h2(w.y); e_x = (f32x4){p0.x, p0.y, p1.x, p1.y}; }
    else e_x = *(const f32x4*)(E.xin_ctx + (size_t)(erow - ML) * DM + ecol);
    const f32x4 e_gs = E.gsn ? *(const f32x4*)(E.gsn + (size_t)2 * DM + ecol) : (f32x4){0.f, 0.f, 0.f, 0.f};
    f32x4 acc[2][4];
#pragma unroll
    for (int rb = 0; rb < 2; ++rb)
#pragma unroll
        for (int cb = 0; cb < 4; ++cb) acc[rb][cb] = (f32x4){0.f, 0.f, 0.f, 0.f};
    constexpr int CH = (KS >= 6) ? 3 : 2, NCH = (KS + CH - 1) / CH;
    bf16x8 fa[2][CH][2], fb[2][CH][4];
#define CTX_LOAD(c, buf) do { _Pragma("unroll") for (int q = 0; q < CH; ++q) if ((c) * CH + q < KS) { \
        _Pragma("unroll") for (int rb = 0; rb < 2; ++rb) fa[buf][q][rb] = *(const bf16x8*)(ap + (size_t)(16 * rb) * K + 32 * ((c) * CH + q)); \
        _Pragma("unroll") for (int cb = 0; cb < 4; ++cb) fb[buf][q][cb] = *(const bf16x8*)(bp + (size_t)(16 * cb) * K + 32 * ((c) * CH + q)); } } while (0)
    CTX_LOAD(0, 0);
#pragma unroll
    for (int c = 0; c < NCH; ++c) {
        __builtin_amdgcn_sched_barrier(0);
        if (c + 1 < NCH) CTX_LOAD(c + 1, (c + 1) & 1);
        __builtin_amdgcn_sched_barrier(0);
#pragma unroll
        for (int q = 0; q < CH; ++q) if (c * CH + q < KS) {
#pragma unroll
            for (int rb = 0; rb < 2; ++rb)
#pragma unroll
                for (int cb = 0; cb < 4; ++cb) acc[rb][cb] = __builtin_amdgcn_mfma_f32_16x16x32_bf16(fb[c & 1][q][cb], fa[c & 1][q][rb], acc[rb][cb], 0, 0, 0);
        }
    }
    __builtin_amdgcn_sched_barrier(0);
#undef CTX_LOAD
    LAS float* red = (LAS float*)lds;
#pragma unroll
    for (int rb = 0; rb < 2; ++rb)
#pragma unroll
        for (int cb = 0; cb < 4; ++cb) *(LAS f32x4*)(red + ((wave * 8 + rb * 4 + cb) * 64 + lane) * 4) = acc[rb][cb];
    __syncthreads();
    {
        const int r = tid >> 4, c4 = tid & 15, rb = r >> 4, j = r & 15, cb = c4 >> 2, q = c4 & 3, ln = q * 16 + j;
        f32x4 sum = (f32x4){0.f, 0.f, 0.f, 0.f};
#pragma unroll
        for (int w = 0; w < 8; ++w) sum += *(const LAS f32x4*)(red + ((w * 8 + rb * 4 + cb) * 64 + ln) * 4);
        const int row = erow, col = ecol;
        const f32x4 y = e_x + (e_gate * E.fac) * sum;
        { u32x2 w; w.x = pk_h2(y.x, y.y); w.y = pk_h2(y.z, y.w); *(u32x2*)(E.xout_bf + (size_t)row * DM + col) = w; }
        if (E.gsn) {
            const f32x4 av = y * e_gs;
            u32x2 w; w.x = cvt_pk_bf16(av.x, av.y); w.y = cvt_pk_bf16(av.z, av.w);
            *(u32x2*)(E.AH + (size_t)row * DM + col) = w;
            float ssq = (y.x * y.x + y.y * y.y) + (y.z * y.z + y.w * y.w);
            ssq += __shfl_xor(ssq, 1); ssq += __shfl_xor(ssq, 2); ssq += __shfl_xor(ssq, 4); ssq += __shfl_xor(ssq, 8);
            if (c4 == 0) E.SS[(size_t)row * 16 + ct] = ssq;
        }
    }
    __syncthreads();
}

#define XB_TMO      128
#define XB_XCNT(j)  (256  + 64 * (j))
#define XB_XSUB(j)  (1280 + 64 * (j))
#define XB_XGEN(j)  (2304 + 64 * (j))
#define XB_TOP      3328
#define XB_TOPGEN   3392
#define XCD_BAR_WORDS 3456
#define XB_SPIN_CAP (1u << 20)
__device__ __forceinline__ unsigned xb_ld(unsigned* p)              { return __hip_atomic_load(p, __ATOMIC_RELAXED, __HIP_MEMORY_SCOPE_AGENT); }
__device__ __forceinline__ unsigned xb_add(unsigned* p, unsigned v) { return __hip_atomic_fetch_add(p, v, __ATOMIC_RELAXED, __HIP_MEMORY_SCOPE_AGENT); }
__device__ __forceinline__ unsigned xb_xcc_id() { return (unsigned)__builtin_amdgcn_s_getreg((3 << 11) | 20) & 0xFu; }
#define XB_SPIN(cond, bar) do { unsigned _sp = 0; while (cond) { __builtin_amdgcn_s_sleep(1); \
    if ((++_sp & 255u) == 0u) { if (xb_ld(&(bar)[XB_TMO])) break; if (_sp > XB_SPIN_CAP) { atomicAdd(&(bar)[XB_TMO], 1u); break; } } } } while (0)
struct XcdBarrier { unsigned* bar; unsigned x; volatile LAS unsigned* st; };
__device__ __forceinline__ XcdBarrier xcd_barrier_post(unsigned* bar, volatile LAS unsigned* st) {
    XcdBarrier b; b.bar = bar; b.x = xb_xcc_id(); b.st = st;
    if (threadIdx.x == 0) (void)xb_add(&bar[XB_XCNT(b.x)], 1u);
    return b;
}
__device__ __forceinline__ void xcd_barrier_complete(unsigned* bar, unsigned x, unsigned& nloc, unsigned& nx) {
    const unsigned G = gridDim.x * gridDim.y * gridDim.z;
    unsigned sum, cnt, mine, sp = 0u;
    for (;;) {
        sum = 0u; cnt = 0u; mine = 0u;
#pragma unroll
        for (unsigned j = 0; j < 16; ++j) { const unsigned c = xb_ld(&bar[XB_XCNT(j)]); sum += c; cnt += (c > 0u) ? 1u : 0u; mine = (j == x) ? c : mine; }
        if (sum == G) break;
        __builtin_amdgcn_s_sleep(1);
        if ((++sp & 255u) == 0u) { if (xb_ld(&bar[XB_TMO])) break; if (sp > XB_SPIN_CAP) { atomicAdd(&bar[XB_TMO], 1u); break; } }
    }
    nloc = mine > 0u ? mine : 1u; nx = cnt > 0u ? cnt : 1u;
}
__device__ __forceinline__ void xcd_barrier(const XcdBarrier& b) {
    asm volatile("s_waitcnt vmcnt(0)" ::: "memory");
    __syncthreads();
    if (threadIdx.x == 0) {
        unsigned* bar = b.bar;
        __builtin_amdgcn_s_waitcnt(0);
        unsigned nloc = b.st[0], nx = b.st[1];
        if (nloc == 0u) { xcd_barrier_complete(bar, b.x, nloc, nx); b.st[0] = nloc; b.st[1] = nx; }
        const unsigned old = xb_add(&bar[XB_XSUB(b.x)], 1u);
        const unsigned gen = old / nloc;
        if (old + 1u == (gen + 1u) * nloc) {
            __builtin_amdgcn_fence(__ATOMIC_RELEASE, "agent");
            asm volatile("s_waitcnt vmcnt(0)" ::: "memory");
            const unsigned og = xb_add(&bar[XB_TOP], 1u);
            const unsigned tg = og / nx;
            if (og + 1u == (tg + 1u) * nx) xb_add(&bar[XB_TOPGEN], 1u);
            else XB_SPIN(xb_ld(&bar[XB_TOPGEN]) == tg, bar);
            __builtin_amdgcn_fence(__ATOMIC_ACQUIRE, "agent");
            xb_add(&bar[XB_XGEN(b.x)], 1u);
            asm volatile("s_waitcnt vmcnt(0)" ::: "memory");
        } else {
            XB_SPIN(xb_ld(&bar[XB_XGEN(b.x)]) == gen, bar);
            __builtin_amdgcn_fence(__ATOMIC_ACQUIRE, "agent");
            asm volatile("s_waitcnt vmcnt(0)" ::: "memory");
        }
    }
    __syncthreads();
}

struct Args { const float* in[19]; float* out; unsigned char* ws; int ph_lo, ph_hi; };
enum { I_X = 0, I_C, I_CTX, I_CCTX, I_WMOD, I_BMOD, I_NORMG, I_W13, I_W2, I_WINA, I_QKG, I_POOLW, I_POOLS, I_WOUTA, I_WINC, I_VNG, I_WSP, I_BSP, I_WOUTC };

__device__ const float INVF[16] = {1.0f, 0.5623413324356079f, 0.3162277638912201f, 0.17782793939113617f, 0.10000000149011612f, 0.05623413249850273f, 0.03162277489900589f, 0.017782794311642647f,
    0.009999999776482582f, 0.005623413249850273f, 0.003162277629598975f, 0.0017782794311642647f, 0.0010000000474974513f, 0.000562341301701963f, 0.0003162277571391314f, 0.00017782794020604342f};

__device__ __forceinline__ void transpose_item(const float* W, int N, bf16_t* WT, int Kd, int k0, int n0, int dst_row0, LAS float* scr, int lane) {
    float tv[32];
#pragma unroll
    for (int i = 0; i < 32; ++i) { const int kk = 2 * i + (lane >> 5); tv[i] = W[(size_t)(k0 + kk) * N + n0 + (lane & 31)]; }
#pragma unroll
    for (int i = 0; i < 32; ++i) { const int kk = 2 * i + (lane >> 5); scr[kk * 33 + (lane & 31)] = tv[i]; }
    asm volatile("s_waitcnt lgkmcnt(0)" ::: "memory");
    const int c = lane & 7;
#pragma unroll
    for (int j = 0; j < 4; ++j) { const int n = (lane >> 3) + 8 * j; const LAS float* s = scr + (8 * c) * 33 + n;
        u32x4 o; o.x = cvt_pk_bf16(s[0 * 33], s[1 * 33]); o.y = cvt_pk_bf16(s[2 * 33], s[3 * 33]); o.z = cvt_pk_bf16(s[4 * 33], s[5 * 33]); o.w = cvt_pk_bf16(s[6 * 33], s[7 * 33]);
        *(u32x4*)(WT + (size_t)(dst_row0 + n) * Kd + k0 + 8 * c) = o; }
    asm volatile("s_waitcnt lgkmcnt(0)" ::: "memory");
}

__device__ __forceinline__ void convert_w13(const Args& a, LAS unsigned char* lds, int mx, int first, int nblk) {
    if ((int)blockIdx.x < first) return;
    int tid_ = threadIdx.x; asm volatile("" : "+v"(tid_));
    const int tid = tid_, lane = tid & 63, wave = __builtin_amdgcn_readfirstlane(tid >> 6);
    LAS float* scr = (LAS float*)(lds + wave * 16384);
    const int gw = ((int)blockIdx.x - first) * 8 + wave, NGW = nblk * 8;
    for (int r = gw; r < 16 * 176; r += NGW) {
        const int kb = r / 176, nb = r % 176, n0 = nb * 32, half = n0 / DFF, idx = n0 % DFF;
        transpose_item(a.in[I_W13] + (size_t)mx * DM * NFF, NFF, (bf16_t*)(a.ws + WS_W13 + (size_t)mx * SZ_W13), DM, kb * 64, n0, (idx >> 7) * 256 + half * 128 + (idx & 127), scr, lane);
    }
}

__device__ __forceinline__ void convert_w2(const Args& a, LAS unsigned char* lds, int mx, int first, int nblk) {
    if ((int)blockIdx.x < first) return;
    int tid_ = threadIdx.x; asm volatile("" : "+v"(tid_));
    const int tid = tid_, lane = tid & 63, wave = __builtin_amdgcn_readfirstlane(tid >> 6);
    LAS float* scr = (LAS float*)(lds + wave * 16384);
    const int gw = ((int)blockIdx.x - first) * 8 + wave, NGW = nblk * 8;
    for (int r = gw; r < 44 * 32; r += NGW) {
        const int kb = r / 32, nb = r % 32;
        transpose_item(a.in[I_W2] + (size_t)mx * DFF * DM, DM, (bf16_t*)(a.ws + WS_W2 + (size_t)mx * SZ_W2), DFF, kb * 64, nb * 32, nb * 32, scr, lane);
    }
}

__device__ __forceinline__ void phase_p0(const Args& a, LAS unsigned char* lds) {
    unsigned char* ws = a.ws;
    int tid_ = threadIdx.x; asm volatile("" : "+v"(tid_));
    const int tid = tid_, lane = tid & 63, wave = __builtin_amdgcn_readfirstlane(tid >> 6), G = gridDim.x;
    LAS float* sl = (LAS float*)(lds + LDS_SILU);
    for (int i = tid; i < 3 * DM; i += 512) { const float cv = (i < 2 * DM) ? a.in[I_C][i] : a.in[I_CCTX][i - 2 * DM]; sl[i] = cv / (1.0f + expf(-cv)); }
    {
        LAS float* scr = (LAS float*)(lds + wave * 16384);
        const int gw = blockIdx.x * 8 + wave, NGW = G * 8;
        constexpr int N13 = 16 * 176, N2 = 44 * 32, NINA = 16 * 40, NOUTA = 8 * 32, NINC = 16 * 64, NOUTC = 16 * 32;
        constexpr int T13 = 8 * N13, T2 = T13 + 8 * N2, TINA = T2 + 2 * NINA, TOUTA = TINA + 2 * NOUTA, TINC = TOUTA + 2 * NINC, TOUTC = TINC + 2 * NOUTC;
        for (int it0 = gw; it0 < TOUTC - 6 * N13; it0 += NGW) {
            const int it = it0 < 2 * N13 ? it0 : it0 + 6 * N13;
            if (it < T13) { const int mx = it / N13, r = it % N13, kb = r / 176, nb = r % 176, n0 = nb * 32, half = n0 / DFF, idx = n0 % DFF;
                if (mx >= 2) continue;
                transpose_item(a.in[I_W13] + (size_t)mx * DM * NFF, NFF, (bf16_t*)(ws + WS_W13 + mx * SZ_W13), DM, kb * 64, n0, (idx >> 7) * 256 + half * 128 + (idx & 127), scr, lane); }
            else if (it < T2) { const int q = it - T13, mx = q / N2, r = q % N2, kb = r / 32, nb = r % 32;
                if (mx >= 2) continue;
                transpose_item(a.in[I_W2] + (size_t)mx * DFF * DM, DM, (bf16_t*)(ws + WS_W2 + mx * SZ_W2), DFF, kb * 64, nb * 32, nb * 32, scr, lane); }
            else if (it < TINA) { const int q = it - T2, mx = q / NINA, r = q % NINA, kb = r / 40, nb = r % 40, n0 = nb * 32;
                int dst;
                if (n0 < 512) { const int head = n0 >> 6, d = n0 & 63; dst = (head >> 2) * 256 + (d >> 5) * 128 + (head & 3) * 32; }
                else if (n0 < 640) { const int head = (n0 - 512) >> 6, d = n0 & 63; dst = 512 + (d >> 5) * 128 + head * 32; }
                else if (n0 < 768) { const int head = (n0 - 640) >> 6, d = n0 & 63; dst = 512 + (d >> 5) * 128 + (2 + head) * 32; }
                else dst = n0;
                transpose_item(a.in[I_WINA] + (size_t)mx * DM * 1280, 1280, (bf16_t*)(ws + WS_WINA + mx * SZ_WINA), DM, kb * 64, n0, dst, scr, lane); }
            else if (it < TOUTA) { const int q = it - TINA, mx = q / NOUTA, r = q % NOUTA, kb = r / 32, nb = r % 32;
                transpose_item(a.in[I_WOUTA] + (size_t)mx * DM * DM, DM, (bf16_t*)(ws + WS_WOUTA + mx * SZ_WSQ), DM, kb * 64, nb * 32, nb * 32, scr, lane); }
            else if (it < TINC) { const int q = it - TOUTA, mx = q / NINC, r = q % NINC, kb = r / 64, nb = r % 64;
                transpose_item(a.in[I_WINC] + (size_t)mx * DM * 2048, 2048, (bf16_t*)(ws + WS_WINC + mx * SZ_WINC), DM, kb * 64, nb * 32, nb * 32, scr, lane); }
            else { const int q = it - TINC, mx = q / NOUTC, r = q % NOUTC, kb = r / 32, nb = r % 32;
                transpose_item(a.in[I_WOUTC] + (size_t)mx * DM * DM, DM, (bf16_t*)(ws + WS_WOUTC + mx * SZ_WSQ), DM, kb * 64, nb * 32, nb * 32, scr, lane); }
        }
    }
    __syncthreads();
    {
        LAS float* red = (LAS float*)lds;
        float* MOD = (float*)(ws + WS_MOD);
        for (int it = blockIdx.x; it < 4 * 144; it += G) {
            const int li = it / 144, j0 = (it % 144) * 64;
            const float* wp = a.in[I_WMOD] + (size_t)li * DM * NMOD + (size_t)(wave * 128) * NMOD + j0 + lane;
            float s0 = 0.f, s1 = 0.f, s2 = 0.f;
#pragma unroll 32
            for (int k = 0; k < 128; ++k) { const float w = wp[(size_t)k * NMOD]; const int kk = wave * 128 + k; s0 += sl[kk] * w; s1 += sl[DM + kk] * w; s2 += sl[2 * DM + kk] * w; }
            red[(wave * 3 + 0) * 64 + lane] = s0; red[(wave * 3 + 1) * 64 + lane] = s1; red[(wave * 3 + 2) * 64 + lane] = s2;
            __syncthreads();
            if (tid < 192) { const int m = tid >> 6; float s = a.in[I_BMOD][li * NMOD + j0 + lane];
#pragma unroll
                for (int w = 0; w < 8; ++w) s += red[(w * 3 + m) * 64 + lane];
                MOD[((size_t)li * 3 + m) * NMOD + j0 + lane] = s; }
            __syncthreads();
        }
    }
    for (int it = blockIdx.x; it < 2 * 4 * 16; it += G) {
        const int e = it >> 6, g = (it >> 4) & 3, nb = it & 15;
        const int n = nb * 64 + lane, k0 = wave * 16;
        const float* wo = a.in[I_WOUTA] + (size_t)e * DM * DM + (size_t)(512 + 128 * g) * DM + n;
        const float* ps = a.in[I_POOLS] + e * 512 + 128 * g;
        const float* pw = a.in[I_POOLW] + ((size_t)(e * 4 + g) * 128 + k0) * 128;
        float acc[16];
#pragma unroll
        for (int kk = 0; kk < 16; ++kk) acc[kk] = 0.f;
        for (int c = 0; c < 128; ++c) { const float wv = wo[(size_t)c * DM] * ps[c];
#pragma unroll
            for (int kk = 0; kk < 16; ++kk) acc[kk] += pw[kk * 128 + c] * wv; }
        bf16_t* dst = (bf16_t*)(ws + WS_WOUTA + e * SZ_WSQ) + (size_t)n * DM + 512 + 128 * g + k0;
        u32x4 w0, w1;
        w0.x = cvt_pk_bf16(acc[0], acc[1]); w0.y = cvt_pk_bf16(acc[2], acc[3]); w0.z = cvt_pk_bf16(acc[4], acc[5]); w0.w = cvt_pk_bf16(acc[6], acc[7]);
        w1.x = cvt_pk_bf16(acc[8], acc[9]); w1.y = cvt_pk_bf16(acc[10], acc[11]); w1.z = cvt_pk_bf16(acc[12], acc[13]); w1.w = cvt_pk_bf16(acc[14], acc[15]);
        *(u32x4*)dst = w0; *(u32x4*)(dst + 8) = w1;
    }
    {
        const int gt = blockIdx.x * 512 + tid, NGT = G * 512;
        bf16_t* wsp = (bf16_t*)(ws + WS_WSP);
        for (int i = gt; i < 2 * 8 * 128 * 128 / 2; i += NGT) { const f32x2 v = *(const f32x2*)(a.in[I_WSP] + 2 * (size_t)i); *(unsigned*)(wsp + 2 * (size_t)i) = cvt_pk_bf16(v.x, v.y); }
        float* rope = (float*)(ws + WS_ROPE);
        for (int i = gt; i < 128 * 16; i += NGT) {
            const int pos = i >> 4, f = i & 15;
            const float ang = (float)pos * INVF[f];
            double x = (double)ang; const double k = rint(x * 0.15915494309189535); x = fma(-k, 6.283185307179586, x);
            const double x2 = x * x; double ts = x, tc = 1.0, ss = x, cc = 1.0;
#pragma unroll
            for (int n = 1; n <= 14; ++n) { tc *= -x2 / (double)((2 * n - 1) * (2 * n)); ts *= -x2 / (double)((2 * n) * (2 * n + 1)); cc += tc; ss += ts; }
            rope[2 * i] = (float)cc; rope[2 * i + 1] = (float)ss;
        }
    }
}

__device__ __forceinline__ void bias_rows(const Args& a, int ls, int first, int nblk) {
    if ((int)blockIdx.x < first) return;
    unsigned char* ws = a.ws;
    int tid_ = threadIdx.x; asm volatile("" : "+v"(tid_));
    const int tid = tid_, lane = tid & 63, wave = __builtin_amdgcn_readfirstlane(tid >> 6);
    const int gw = ((int)blockIdx.x - first) * 8 + wave, NGW = nblk * 8;
    const float* MOD = (const float*)(ws + WS_MOD);
    {
        const int li = ls / 3, s = ls % 3;
        const bf16_t* Wt; int Nr;
        if (s == 1) { if (li & 1) { Wt = (const bf16_t*)(ws + WS_WINC + (li >> 1) * SZ_WINC); Nr = 2048; } else { Wt = (const bf16_t*)(ws + WS_WINA + (li >> 1) * SZ_WINA); Nr = 1280; } }
        else { Wt = (const bf16_t*)(ws + WS_W13 + (size_t)(li * 2 + (s >> 1)) * SZ_W13); Nr = NFF; }
        float sh[3][16];
#pragma unroll
        for (int mi = 0; mi < 3; ++mi)
#pragma unroll
            for (int j = 0; j < 2; ++j) { const float* sp = MOD + ((size_t)li * 3 + mi) * NMOD + (3 * s) * DM + 512 * j + 8 * lane;
                const f32x4 v0 = *(const f32x4*)sp, v1 = *(const f32x4*)(sp + 4);
                sh[mi][8 * j + 0] = v0.x; sh[mi][8 * j + 1] = v0.y; sh[mi][8 * j + 2] = v0.z; sh[mi][8 * j + 3] = v0.w; sh[mi][8 * j + 4] = v1.x; sh[mi][8 * j + 5] = v1.y; sh[mi][8 * j + 6] = v1.z; sh[mi][8 * j + 7] = v1.w; }
        float* BI = (float*)(ws + WS_BIAS) + (size_t)ls * 3 * NFF;
        for (int n4 = gw * 4; n4 < Nr; n4 += NGW * 4) {
            u32x4 w0[4], w1[4];
#pragma unroll
            for (int r = 0; r < 4; ++r) { w0[r] = *(const u32x4*)(Wt + (size_t)(n4 + r) * DM + 8 * lane); w1[r] = *(const u32x4*)(Wt + (size_t)(n4 + r) * DM + 512 + 8 * lane); }
            float dsum[4][3];
#pragma unroll
            for (int r = 0; r < 4; ++r) {
                float wv[16];
                wv[0] = bflo(w0[r].x); wv[1] = bfhi(w0[r].x); wv[2] = bflo(w0[r].y); wv[3] = bfhi(w0[r].y); wv[4] = bflo(w0[r].z); wv[5] = bfhi(w0[r].z); wv[6] = bflo(w0[r].w); wv[7] = bfhi(w0[r].w);
                wv[8] = bflo(w1[r].x); wv[9] = bfhi(w1[r].x); wv[10] = bflo(w1[r].y); wv[11] = bfhi(w1[r].y); wv[12] = bflo(w1[r].z); wv[13] = bfhi(w1[r].z); wv[14] = bflo(w1[r].w); wv[15] = bfhi(w1[r].w);
                float d0 = 0.f, d1 = 0.f, d2 = 0.f;
#pragma unroll
                for (int k = 0; k < 16; ++k) { d0 += sh[0][k] * wv[k]; d1 += sh[1][k] * wv[k]; d2 += sh[2][k] * wv[k]; }
                dsum[r][0] = wave_sum(d0); dsum[r][1] = wave_sum(d1); dsum[r][2] = wave_sum(d2);
            }
            if (lane < 12) { const int r = lane & 3, m = lane >> 2; float v = dsum[0][0];
#pragma unroll
                for (int rr = 0; rr < 4; ++rr)
#pragma unroll
                    for (int mm = 0; mm < 3; ++mm) if (r == rr && m == mm) v = dsum[rr][mm];
                BI[(size_t)m * NFF + n4 + r] = v; }
        }
    }
}

__device__ __forceinline__ void phase_p0b(const Args& a) {
    unsigned char* ws = a.ws;
    int tid_ = threadIdx.x; asm volatile("" : "+v"(tid_));
    const int tid = tid_, lane = tid & 63, wave = __builtin_amdgcn_readfirstlane(tid >> 6), G = gridDim.x;
    const int gw = blockIdx.x * 8 + wave, NGW = G * 8;
    const float* MOD = (const float*)(ws + WS_MOD);
    {
        float* GS = (float*)(ws + WS_GS);
        for (int i = blockIdx.x * 512 + tid; i < 12 * 3 * DM; i += G * 512) { const int col = i & 1023, mi = (i >> 10) % 3, ls = i / (3 * DM), li = ls / 3, s = ls % 3;
            GS[i] = a.in[I_NORMG][(size_t)ls * DM + col] * (1.0f + MOD[((size_t)li * 3 + mi) * NMOD + (3 * s + 1) * DM + col]); }
    }
    for (int ls = 0; ls < 12; ++ls) if (ls < 3 || ls % 3 == 1) bias_rows(a, ls, 0, G);
    {
        bf16_t* AH = (bf16_t*)(ws + WS_AH); float* SS = (float*)(ws + WS_SS);
        for (int row = gw; row < MT; row += NGW) {
            const int mi = row < SEQ ? 0 : (row < ML ? 1 : 2);
            const float* xr = (row < ML) ? a.in[I_X] + (size_t)row * DM : a.in[I_CTX] + (size_t)(row - ML) * DM;
            const float* gp = a.in[I_NORMG];
            const float* scp = MOD + (size_t)mi * NMOD + DM;
            float ssq = 0.f;
#pragma unroll
            for (int j = 0; j < 4; ++j) { const int col = 256 * j + 4 * lane;
                const f32x4 v = *(const f32x4*)(xr + col), g = *(const f32x4*)(gp + col), sc = *(const f32x4*)(scp + col);
                ssq += (v.x * v.x + v.y * v.y) + (v.z * v.z + v.w * v.w);
                const f32x4 o = v * g * (sc + 1.0f);
                u32x2 w; w.x = cvt_pk_bf16(o.x, o.y); w.y = cvt_pk_bf16(o.z, o.w);
                *(u32x2*)(AH + (size_t)row * DM + col) = w; }
            ssq = wave_sum(ssq);
            if (lane < 16) SS[(size_t)row * 16 + lane] = (lane == 0) ? ssq : 0.f;
        }
    }
}

template <int HW> __device__ __forceinline__ void pool_rows(const unsigned* __restrict__ Pc, bf16_t* __restrict__ AOc, int t0, int n) {
    unsigned w[32 + 2 * HW];
#pragma unroll
    for (int j = 0; j < 32 + 2 * HW; ++j) { const int t = t0 - HW + j; w[j] = (t >= 0 && t < n) ? Pc[(size_t)t * 256] : 0u; }
    float s0 = 0.f, s1 = 0.f;
#pragma unroll
    for (int j = 0; j < 2 * HW; ++j) { s0 += bflo(w[j]); s1 += bfhi(w[j]); }
#pragma unroll
    for (int i = 0; i < 32; ++i) {
        const int t = t0 + i, lo = max(t - HW, 0), hi_ = min(t + HW, n);
        const float inv = 1.0f / (float)(hi_ - lo);
        *(unsigned*)(AOc + (size_t)t * DM) = cvt_pk_bf16(s0 * inv - bflo(w[i + HW]), s1 * inv - bfhi(w[i + HW]));
        if (i < 31) { s0 += bflo(w[i + 2 * HW]) - bflo(w[i]); s1 += bfhi(w[i + 2 * HW]) - bfhi(w[i]); }
    }
}
__device__ __forceinline__ void pool_unit(const bf16_t* P, bf16_t* AO, int unit) {
    int tid_ = threadIdx.x; asm volatile("" : "+v"(tid_));
    const int tid = tid_, half = tid >> 8, cp = tid & 255, g = __builtin_amdgcn_readfirstlane(cp >> 6);
    const int row0 = unit * 64 + half * 32;
    int base, n;
    if (row0 < ML) { base = row0 & ~(SEQ - 1); n = SEQ; } else { base = ML + ((row0 - ML) & ~(CTXL - 1)); n = CTXL; }
    const int t0 = row0 - base;
    const unsigned* Pc = (const unsigned*)(P + (size_t)base * 512) + cp;
    bf16_t* AOc = AO + (size_t)base * DM + 512 + 2 * cp;
    if (g == 0) pool_rows<1>(Pc, AOc, t0, n); else if (g == 1) pool_rows<2>(Pc, AOc, t0, n); else if (g == 2) pool_rows<4>(Pc, AOc, t0, n); else pool_rows<8>(Pc, AOc, t0, n);
}

__device__ __forceinline__ void spatial_unit(const Args& a, LAS unsigned char* lds, int o, int ch, int g) {
    unsigned char* ws = a.ws;
    int tid_ = threadIdx.x; asm volatile("" : "+v"(tid_));
    const int tid = tid_, lane = tid & 63, wave = __builtin_amdgcn_readfirstlane(tid >> 6);
    const bf16_t* U = (const bf16_t*)(ws + WS_H); const bf16_t* V = U + (size_t)MT * DM; const float* VSS = (const float*)(ws + WS_VSS);
    bf16_t* Gout = (bf16_t*)(ws + WS_AO);
    LAS bf16_t* VnT = (LAS bf16_t*)lds;
    LAS float* rst = (LAS float*)(lds + 128 * 136 * 2);
    const int r0 = ch * 128;
    if (tid < 128) { const float* p = VSS + (size_t)(r0 + tid) * 16; const f32x4 v0 = *(const f32x4*)p, v1 = *(const f32x4*)(p + 4), v2 = *(const f32x4*)(p + 8), v3 = *(const f32x4*)(p + 12);
        const float s = ((v0.x + v0.y) + (v0.z + v0.w)) + ((v1.x + v1.y) + (v1.z + v1.w)) + ((v2.x + v2.y) + (v2.z + v2.w)) + ((v3.x + v3.y) + (v3.z + v3.w));
        rst[tid] = 1.0f / sqrtf(s * (1.0f / 1024.0f) + EPS); }
    __syncthreads();
    const float* vg = a.in[I_VNG] + (size_t)o * DM + g * 128;
#pragma unroll
    for (int it = 0; it < 4; ++it) {
        const int idx = tid + 512 * it, q = idx >> 4, c8 = (idx & 15) * 8;
        const u32x4 w = *(const u32x4*)(V + (size_t)(r0 + q) * DM + g * 128 + c8);
        const f32x4 g0 = *(const f32x4*)(vg + c8), g1 = *(const f32x4*)(vg + c8 + 4);
        const float rs = rst[q];
        const float v[8] = {bflo(w.x) * rs * g0.x, bfhi(w.x) * rs * g0.y, bflo(w.y) * rs * g0.z, bfhi(w.y) * rs * g0.w, bflo(w.z) * rs * g1.x, bfhi(w.z) * rs * g1.y, bflo(w.w) * rs * g1.z, bfhi(w.w) * rs * g1.w};
#pragma unroll
        for (int e = 0; e < 8; e += 2) { const unsigned pk = cvt_pk_bf16(v[e], v[e + 1]); VnT[(c8 + e) * 136 + q] = (bf16_t)(pk & 0xffffu); VnT[(c8 + e + 1) * 136 + q] = (bf16_t)(pk >> 16); }
    }
    __syncthreads();
    const int pl = lane & 15, kq = lane >> 4, p = wave * 16 + pl;
    const bf16_t* wsp = (const bf16_t*)(ws + WS_WSP) + ((size_t)(o * 8 + g) * 128 + p) * 128;
    bf16x8 bw[4];
#pragma unroll
    for (int ks = 0; ks < 4; ++ks) bw[ks] = *(const bf16x8*)(wsp + 32 * ks + 8 * kq);
    f32x4 acc[8];
#pragma unroll
    for (int nb = 0; nb < 8; ++nb) { acc[nb] = (f32x4){0.f, 0.f, 0.f, 0.f};
#pragma unroll
        for (int ks = 0; ks < 4; ++ks) { const bf16x8 av = *(const LAS bf16x8*)(VnT + (16 * nb + pl) * 136 + 32 * ks + 8 * kq);
            acc[nb] = __builtin_amdgcn_mfma_f32_16x16x32_bf16(av, bw[ks], acc[nb], 0, 0, 0); } }
    const float bsp = a.in[I_BSP][(size_t)(o * 8 + g) * 128 + p];
    const size_t ro = (size_t)(r0 + p) * DM + g * 128 + 4 * kq;
#pragma unroll
    for (int nb = 0; nb < 8; ++nb) { const u32x2 uw = *(const u32x2*)(U + ro + 16 * nb);
        u32x2 w; w.x = cvt_pk_bf16(bflo(uw.x) * (acc[nb].x + bsp), bfhi(uw.x) * (acc[nb].y + bsp)); w.y = cvt_pk_bf16(bflo(uw.y) * (acc[nb].z + bsp), bfhi(uw.y) * (acc[nb].w + bsp));
        *(u32x2*)(Gout + ro + 16 * nb) = w; }
    __syncthreads();
}

__global__ void __launch_bounds__(512, 2) fwd_megakernel(Args a) {
    extern __shared__ __attribute__((aligned(16))) unsigned char lds_raw[];
    LAS unsigned char* lds = (LAS unsigned char*)lds_raw;
    unsigned char* ws = a.ws;
    const int G = gridDim.x, lo = a.ph_lo, hi = a.ph_hi;
    int ph = 0;
    volatile LAS unsigned* misc = (volatile LAS unsigned*)(lds + LDS_MISC);
    XcdBarrier bar; bar.bar = (unsigned*)(ws + WS_CTL); bar.x = 0; bar.st = misc;
    if (hi - lo > 1) {
        if (threadIdx.x == 0) { misc[0] = 0u; misc[1] = 0u; }
        __syncthreads();
        bar = xcd_barrier_post((unsigned*)(ws + WS_CTL), misc);
    }
#define PHASE_BEGIN if (ph >= lo && ph < hi) {
#define PHASE_END   if (ph + 1 < hi) { if (lo < 0) cg::this_grid().sync(); else xcd_barrier(bar); } } ++ph;

    PHASE_BEGIN phase_p0(a, lds); PHASE_END
    PHASE_BEGIN phase_p0b(a); PHASE_END

    const float* MOD = (const float*)(ws + WS_MOD);
    bf16_t* X = (bf16_t*)(ws + WS_X); bf16_t* AH = (bf16_t*)(ws + WS_AH); float* SS = (float*)(ws + WS_SS); bf16_t* H = (bf16_t*)(ws + WS_H);
    bf16_t* AO = (bf16_t*)(ws + WS_AO);
    for (int L = 0; L < 4; ++L) {
        const bool even = (L & 1) == 0;
        const int Mfull = (L <= 2) ? MT : ML;
        const int Mlate = (L <= 1) ? MT : ML;
        const float* BIAS = (const float*)(ws + WS_BIAS) + (size_t)(L * 3) * 3 * NFF;
        const float* GS = (const float*)(ws + WS_GS) + (size_t)(L * 3) * 3 * DM;
        const float* MODL = MOD + (size_t)L * 3 * NMOD;
        PHASE_BEGIN {
            pg8::Gemm g{AH, (const bf16_t*)(ws + WS_W13 + (size_t)(L * 2) * SZ_W13), Mfull, NFF, DM}; pg8::StaticOrder S; S.init(Mfull, NFF, G, (int)blockIdx.x);
            pg8::EpiSwiGLU E{H, SS, BIAS};
            pg8::gemm_phase<pg8::EpiSwiGLU, pg8::StaticOrder, true, true>(lds, g, S, E);
            { const int rem = S.nwg % G, first = rem ? rem : 0, nidle = G - first;
              if (L >= 1) bias_rows(a, L * 3 + 2, first, nidle);
              if (L < 3) convert_w2(a, lds, (L + 1) * 2, first, nidle); }
        } PHASE_END
        PHASE_BEGIN {
            const bf16_t* Wt = (const bf16_t*)(ws + WS_W2 + (size_t)(L * 2) * SZ_W2);
            pg8::Gemm g{H, Wt, ML, DM, DFF}; pg8::StaticOrder S; S.init(ML, DM, G, (int)blockIdx.x);
            pg8::EpiResid E{a.in[I_X], a.in[I_CTX], L == 0 ? nullptr : X, X, nullptr, MODL + 2 * DM, GS + 3 * DM, AH, SS, 0.5f, 0};
            if (Mfull == MT) for (int t = blockIdx.x; t < 256; t += G) ctx_gemm_resid<11>(lds, H, Wt, E, t);
            pg8::gemm_phase<pg8::EpiResid, pg8::StaticOrder, true, true>(lds, g, S, E);
        } PHASE_END
        PHASE_BEGIN {
            if (even) {
                pg8::Gemm g{AH, (const bf16_t*)(ws + WS_WINA + (size_t)(L >> 1) * SZ_WINA), Mfull, 1280, DM}; pg8::StaticOrder S; S.init(Mfull, 1280, G, (int)blockIdx.x);
                pg8::EpiInA E{SS, BIAS + 3 * NFF, a.in[I_QKG] + (L >> 1) * 128, (const float*)(ws + WS_ROPE), (bf16_t*)(ws + WS_Q), (bf16_t*)(ws + WS_KB), (bf16_t*)(ws + WS_VB), (bf16_t*)(ws + WS_P)};
                pg8::gemm_phase<pg8::EpiInA, pg8::StaticOrder, true, true>(lds, g, S, E);
                { const int rem = S.nwg % G, first = rem ? rem : 0; if (L < 3) { convert_w13(a, lds, (L + 1) * 2, first, G - first); convert_w2(a, lds, (L + 1) * 2 + 1, first, G - first); } }
            } else {
                pg8::Gemm g{AH, (const bf16_t*)(ws + WS_WINC + (size_t)(L >> 1) * SZ_WINC), Mlate, 2048, DM}; pg8::StaticOrder S; S.init(Mlate, 2048, G, (int)blockIdx.x);
                pg8::EpiInC E{SS, BIAS + 3 * NFF, H, H + (size_t)MT * DM, (float*)(ws + WS_VSS)};
                pg8::gemm_phase<pg8::EpiInC, pg8::StaticOrder, true, true>(lds, g, S, E);
                { const int rem = S.nwg % G, first = rem ? rem : 0; if (L < 3) { convert_w13(a, lds, (L + 1) * 2, first, G - first); convert_w2(a, lds, (L + 1) * 2 + 1, first, G - first); } }
            }
        } PHASE_END
        PHASE_BEGIN {
            if (even) {
                const attn_body::bf16* Qb = (const attn_body::bf16*)(ws + WS_Q); const attn_body::bf16* Kb = (const attn_body::bf16*)(ws + WS_KB); const attn_body::bf16* Vb = (const attn_body::bf16*)(ws + WS_VB);
                attn_body::bf16* Ob = (attn_body::bf16*)AO;
                const int bid = blockIdx.x;
                for (int r = 0; ; ++r) {
                    int uidx;
                    if (G == 256) { if (r >= 2) break; const int x = bid & 7; uidx = (x >> 1) * 128 + (x & 1) * 64 + (bid >> 3) * 2 + r; }
                    else { uidx = bid + r * G; if (uidx >= 512) break; }
                    const int combo = uidx >> 7, idx = uidx & 127, b = combo >> 1, kvh = combo & 1, h = kvh * 4 + (idx >> 5), qb = idx & 31;
                    const size_t qrow = (size_t)b * SEQ + qb * 256;
                    attn_body::attn_unit<8>(Qb + qrow * 512 + h * 64, Kb + (size_t)(b * 2 + kvh) * KVROWS * 64, Vb + (size_t)(b * 2 + kvh) * KVROWS * 64, KVROWS / 64, Ob + qrow * DM + h * 64, (char*)lds_raw);
                }
                const int nctx = (L == 0) ? 16 : 0, npool = (L == 0) ? MT / 64 : ML / 64;
                for (int it = blockIdx.x; it < nctx + npool; it += G) {
                    if (it < nctx) { const int b = it >> 3, h = it & 7, kvh = h >> 2; const size_t qrow = (size_t)ML + b * CTXL;
                        attn_body::attn_unit<8>(Qb + qrow * 512 + h * 64, Kb + (size_t)(b * 2 + kvh) * KVROWS * 64, Vb + (size_t)(b * 2 + kvh) * KVROWS * 64, CTXL / 64, Ob + qrow * DM + h * 64, (char*)lds_raw); }
                    else pool_unit((const bf16_t*)(ws + WS_P), AO, it - nctx);
                }
            } else {
                const int nch = Mlate / 128;
                for (int it = blockIdx.x; it < nch * 8; it += G) spatial_unit(a, lds, L >> 1, it >> 3, it & 7);
            }
        } PHASE_END
        PHASE_BEGIN {
            const bf16_t* Wt = even ? (const bf16_t*)(ws + WS_WOUTA + (size_t)(L >> 1) * SZ_WSQ) : (const bf16_t*)(ws + WS_WOUTC + (size_t)(L >> 1) * SZ_WSQ);
            pg8::Gemm g{AO, Wt, ML, DM, DM}; pg8::StaticOrder S; S.init(ML, DM, G, (int)blockIdx.x);
            pg8::EpiResid E{a.in[I_X], a.in[I_CTX], X, X, nullptr, MODL + 5 * DM, GS + 2 * 3 * DM, AH, SS, 1.0f, 0};
            if (Mlate == MT) for (int t = blockIdx.x; t < 256; t += G) ctx_gemm_resid<4>(lds, AO, Wt, E, t);
            pg8::gemm_phase<pg8::EpiResid, pg8::StaticOrder, true, true>(lds, g, S, E);
        } PHASE_END
        PHASE_BEGIN {
            pg8::Gemm g{AH, (const bf16_t*)(ws + WS_W13 + (size_t)(L * 2 + 1) * SZ_W13), Mlate, NFF, DM}; pg8::StaticOrder S; S.init(Mlate, NFF, G, (int)blockIdx.x);
            pg8::EpiSwiGLU E{H, SS, BIAS + 2 * 3 * NFF};
            pg8::gemm_phase<pg8::EpiSwiGLU, pg8::StaticOrder, true, true>(lds, g, S, E);
            { const int rem = S.nwg % G, first = rem ? rem : 0, nidle = G - first;
              if (L < 3) { convert_w13(a, lds, (L + 1) * 2 + 1, first, nidle); bias_rows(a, (L + 1) * 3, first, nidle); } }
        } PHASE_END
        PHASE_BEGIN {
            const bf16_t* Wt = (const bf16_t*)(ws + WS_W2 + (size_t)(L * 2 + 1) * SZ_W2);
            pg8::Gemm g{H, Wt, ML, DM, DFF}; pg8::StaticOrder S; S.init(ML, DM, G, (int)blockIdx.x);
            pg8::EpiResid E{a.in[I_X], a.in[I_CTX], X, X, L == 3 ? a.out : nullptr, MODL + 8 * DM, L == 3 ? nullptr : GS + (size_t)3 * 3 * DM, AH, SS, 0.5f, 0};
            if (Mlate == MT) for (int t = blockIdx.x; t < 256; t += G) ctx_gemm_resid<11>(lds, H, Wt, E, t);
            pg8::gemm_phase<pg8::EpiResid, pg8::StaticOrder, true, true>(lds, g, S, E);
        } PHASE_END
    }
#undef PHASE_BEGIN
#undef PHASE_END
}

constexpr int N_PHASES = 2 + 4 * 7;

extern "C" void kernel_launch(void* const* d_in, const int* in_sizes, int n_in, void* d_out, int out_size, void* d_ws, size_t ws_size, hipStream_t stream) {
    static int grid = 0;
    if (grid == 0) {
        if (n_in != 19 || ws_size < WS_END) { fprintf(stderr, "kernel_launch: unexpected inputs (n_in %d, ws %zu, need %zu)\n", n_in, ws_size, (size_t)WS_END); grid = -1; return; }
        int dev = 0, cus = 0, per_cu = 0;
        hipGetDevice(&dev);
        hipDeviceGetAttribute(&cus, hipDeviceAttributeMultiprocessorCount, dev);
        if (hipFuncSetAttribute((const void*)fwd_megakernel, hipFuncAttributeMaxDynamicSharedMemorySize, LDS_BYTES) != hipSuccess) { fprintf(stderr, "kernel_launch: hipFuncSetAttribute failed\n"); grid = -1; return; }
        if (hipOccupancyMaxActiveBlocksPerMultiprocessor(&per_cu, (const void*)fwd_megakernel, 512, LDS_BYTES) != hipSuccess || per_cu < 1) { fprintf(stderr, "kernel_launch: occupancy query says %d\n", per_cu); per_cu = 1; }
        (void)hipGetLastError();
        grid = cus * (per_cu > 1 ? 1 : per_cu);
        if (grid <= 0) grid = 256;
    }
    if (grid < 0) return;
    Args a{};
    for (int i = 0; i < 19; ++i) a.in[i] = (const float*)d_in[i];
    a.out = (float*)d_out; a.ws = (unsigned char*)d_ws;
#if MK_PER_PHASE
    for (int p = 0; p < N_PHASES; ++p) { a.ph_lo = p; a.ph_hi = p + 1; hipLaunchKernelGGL(fwd_megakernel, dim3(grid), dim3(512), LDS_BYTES, stream, a); }
#else
    a.ph_lo = 0; a.ph_hi = N_PHASES;
    if (hipMemsetAsync((char*)d_ws + WS_CTL, 0, CTL_BYTES, stream) != hipSuccess) { fprintf(stderr, "kernel_launch: memset of the barrier words failed\n"); return; }
    void* args[] = {&a};
    hipError_t e = hipLaunchCooperativeKernel((const void*)fwd_megakernel, dim3(grid), dim3(512), args, LDS_BYTES, stream);
    if (e != hipSuccess) fprintf(stderr, "cooperative launch failed: %s (grid %d)\n", hipGetErrorString(e), grid);
#endif
}
```
